# Optimizing an MI355X kernel written in HIP

```python
import jax
import jax.numpy as jnp
from jax import lax
import numpy as np

D_MODEL = 1024
BATCH = 32
SEQ = 2048
DEPTH = 1

CTX_LEN = 256
GRID_W = 64
N_SUBLAYERS = 3
D_FF = 2816
FFN_HALF = 0.5
GLA_HEADS = 4
GLA_DK = 64
GLA_DV = 128
GLA_GATE_RANK = 16
GLA_GATE_NORMALIZER = 16.0
HGRN_HEADS = 4
HGRN_DK = 128
HGRN_DV = 128
GLA_QK = GLA_HEADS * GLA_DK
GLA_V = GLA_HEADS * GLA_DV
HGRN_K = HGRN_HEADS * HGRN_DK
HGRN_V = HGRN_HEADS * HGRN_DV
MIX_WIDTH = GLA_V + HGRN_V
IN_SPLITS = (GLA_QK, GLA_QK, GLA_V, GLA_V, GLA_GATE_RANK, GLA_GATE_RANK, HGRN_K, HGRN_K, HGRN_K, HGRN_V, HGRN_V)
IN_WIDTH = sum(IN_SPLITS)
CHUNK = 32
LN_EPS = 1e-5
NORM_EPS = 1e-6
POS_THETA = 10000.0
DN_ALPHA = (2.0 * DEPTH) ** 0.25
DN_BETA = (8.0 * DEPTH) ** -0.25

kernel_name = "hybrid_gla_hgrn2_dit_layer"


def layer_norm(x, gain=None, bias=None):
    xf = x.astype(jnp.float32)
    mu = jnp.mean(xf, axis=-1, keepdims=True)
    var = jnp.mean(jnp.square(xf - mu), axis=-1, keepdims=True)
    y = (xf - mu) * lax.rsqrt(var + LN_EPS)
    if gain is not None:
        y = y * gain.astype(jnp.float32) + bias.astype(jnp.float32)
    return y.astype(x.dtype)


def modulate(x, m, i):
    return layer_norm(x) * (1.0 + m[:, 3 * i][:, None, :]) + m[:, 3 * i + 1][:, None, :]


def residual_post_norm(x, y, gate, weight, gain, bias):
    return layer_norm(DN_ALPHA * x + weight * gate[:, None, :] * y, gain, bias)


def swiglu(h, w_in, w_out):
    gate, up = jnp.split(h @ w_in, 2, axis=-1)
    return (jax.nn.silu(gate) * up) @ w_out


def sincos_2d(rows, width, dim):
    r = jnp.repeat(jnp.arange(rows), width)
    col = jnp.tile(jnp.arange(width), rows)
    quarter = dim // 4
    omega = 1.0 / POS_THETA ** (jnp.arange(quarter, dtype=jnp.float32) / quarter)

    def emb(p):
        a = p.astype(jnp.float32)[:, None] * omega[None, :]
        return jnp.concatenate([jnp.sin(a), jnp.cos(a)], axis=-1)

    return jnp.concatenate([emb(r), emb(col)], axis=-1)


def to_heads(a, n_heads):
    b, t, _ = a.shape
    return a.reshape(b, t, n_heads, -1).transpose(0, 2, 1, 3)


def from_heads(a):
    b, h, t, d = a.shape
    return a.transpose(0, 2, 1, 3).reshape(b, t, h * d)


def chunk_gated_linear_attention(q, k, v, log_f, s0):
    bsz, nh, t, _ = q.shape
    dv = v.shape[-1]
    n_chunks = t // CHUNK

    def split(a):
        return a.astype(jnp.float32).reshape(bsz, nh, n_chunks, CHUNK, a.shape[-1]).transpose(2, 0, 1, 3, 4)

    lower_tri = jnp.tril(jnp.ones((CHUNK, CHUNK), dtype=bool))

    def step(s, blk):
        qb, kb, vb, gb = blk
        b = jnp.cumsum(gb, axis=-2)
        b_last = b[..., -1:, :]
        q_dec = qb * jnp.exp(b)
        k_inv = kb * jnp.exp(-b)
        k_tail = kb * jnp.exp(b_last - b)
        att = jnp.where(lower_tri, jnp.einsum("bhik,bhjk->bhij", q_dec, k_inv), 0.0)
        o = jnp.einsum("bhij,bhjv->bhiv", att, vb) + jnp.einsum("bhik,bhkv->bhiv", q_dec, s)
        s_new = jnp.swapaxes(jnp.exp(b_last), -1, -2) * s + jnp.einsum("bhjk,bhjv->bhkv", k_tail, vb)
        return s_new, o

    s_final, o = lax.scan(step, s0.astype(jnp.float32), (split(q), split(k), split(v), split(log_f)))
    return o.transpose(1, 2, 0, 3, 4).reshape(bsz, nh, t, dv), s_final


def bidirectional_scan(lat, ctx):
    q, k_f, k_b, v, g_f, g_b = lat
    qc, kc_f, kc_b, vc, gc_f, gc_b = ctx

    def flip(a):
        return jnp.flip(a, axis=2)

    zero = jnp.zeros(qc.shape[:2] + (qc.shape[-1], vc.shape[-1]), jnp.float32)
    oc_f, sc_f = chunk_gated_linear_attention(qc, kc_f, vc, gc_f, zero)
    oc_b, sc_b = chunk_gated_linear_attention(flip(qc), flip(kc_b), flip(vc), flip(gc_b), zero)
    o_f, _ = chunk_gated_linear_attention(q, k_f, v, g_f, sc_f)
    o_b, _ = chunk_gated_linear_attention(flip(q), flip(k_b), flip(v), flip(g_b), sc_b)
    return o_f + flip(o_b), oc_f + flip(oc_b)


def mixer_features(h, w_in, a2_f, a2_b, a_bias_f, a_bias_b, lb_f, lb_b):
    split_points = np.cumsum(IN_SPLITS)[:-1].tolist()
    (g_q, g_k, g_v, g_gate, g_lr_f, g_lr_b, r_q, r_f_f, r_f_b, r_i, r_gate) = jnp.split(h @ w_in, split_points, axis=-1)

    def gla_log_decay(lr, a2, bias):
        return to_heads(jax.nn.log_sigmoid((lr @ a2 + bias).astype(jnp.float32)) / GLA_GATE_NORMALIZER, GLA_HEADS)

    def hgrn_forget(z, lb):
        f = lb + (1.0 - lb) * jax.nn.sigmoid(z.astype(jnp.float32))
        return to_heads(jnp.log(f), HGRN_HEADS), to_heads(1.0 - f, HGRN_HEADS)

    k_gla = to_heads(g_k, GLA_HEADS)
    gla = (to_heads(g_q * GLA_DK ** -0.5, GLA_HEADS), k_gla, k_gla, to_heads(g_v, GLA_HEADS),
           gla_log_decay(g_lr_f, a2_f, a_bias_f), gla_log_decay(g_lr_b, a2_b, a_bias_b))
    logf_f, k_f = hgrn_forget(r_f_f, lb_f)
    logf_b, k_b = hgrn_forget(r_f_b, lb_b)
    hgrn = (to_heads(jax.nn.silu(r_q) * HGRN_DK ** -0.5, HGRN_HEADS), k_f, k_b, to_heads(r_i, HGRN_HEADS), logf_f, logf_b)
    return gla, hgrn, g_gate, r_gate


def gated_head_norm(o, gain, gate):
    o = o * lax.rsqrt(jnp.mean(jnp.square(o), axis=-1, keepdims=True) + NORM_EPS) * gain.astype(jnp.float32)
    return from_heads(o) * jax.nn.silu(gate.astype(jnp.float32))


def token_mixer(h, hc, with_ctx_output, w_in, a2_f, a2_b, a_bias_f, a_bias_b, lb_f, lb_b, gla_gain, hgrn_gain, w_out):
    gla, hgrn, gla_gate, hgrn_gate = mixer_features(h, w_in, a2_f, a2_b, a_bias_f, a_bias_b, lb_f, lb_b)
    gla_c, hgrn_c, gla_gate_c, hgrn_gate_c = mixer_features(hc, w_in, a2_f, a2_b, a_bias_f, a_bias_b, lb_f, lb_b)
    o_gla, oc_gla = bidirectional_scan(gla, gla_c)
    o_hgrn, oc_hgrn = bidirectional_scan(hgrn, hgrn_c)

    def project(o1, g1, o2, g2):
        merged = jnp.concatenate([gated_head_norm(o1, gla_gain, g1), gated_head_norm(o2, hgrn_gain, g2)], axis=-1)
        return merged.astype(w_out.dtype) @ w_out

    y = project(o_gla, gla_gate, o_hgrn, hgrn_gate)
    yc = project(oc_gla, gla_gate_c, oc_hgrn, hgrn_gate_c) if with_ctx_output else None
    return y, yc


def trunk_layer(x, xc, m, mc, update_ctx, ln_gain, ln_bias, ffn1_w_in, ffn1_w_out, w_mix_in,
                a2_f, a2_b, a_bias_f, a_bias_b, lb_f, lb_b, gla_gain, hgrn_gain, w_mix_out, ffn2_w_in, ffn2_w_out):
    x = residual_post_norm(x, swiglu(modulate(x, m, 0), ffn1_w_in, ffn1_w_out), m[:, 2], FFN_HALF, ln_gain[0], ln_bias[0])
    xc = residual_post_norm(xc, swiglu(modulate(xc, mc, 0), ffn1_w_in, ffn1_w_out), mc[:, 2], FFN_HALF, ln_gain[0], ln_bias[0])
    y, yc = token_mixer(modulate(x, m, 1), modulate(xc, mc, 1), update_ctx, w_mix_in, a2_f, a2_b, a_bias_f, a_bias_b,
                        lb_f, lb_b, gla_gain, hgrn_gain, w_mix_out)
    x = residual_post_norm(x, y, m[:, 5], 1.0, ln_gain[1], ln_bias[1])
    x = residual_post_norm(x, swiglu(modulate(x, m, 2), ffn2_w_in, ffn2_w_out), m[:, 8], FFN_HALF, ln_gain[2], ln_bias[2])
    if update_ctx:
        xc = residual_post_norm(xc, yc, mc[:, 5], 1.0, ln_gain[1], ln_bias[1])
        xc = residual_post_norm(xc, swiglu(modulate(xc, mc, 2), ffn2_w_in, ffn2_w_out), mc[:, 8], FFN_HALF, ln_gain[2], ln_bias[2])
    return x, xc


def setup_inputs(seed: int = 0) -> dict:
    key = jax.random.key(seed)
    ks = jax.random.split(key, 24)
    f32 = jnp.float32

    def w(k, shape, fan_in, scale=1.0):
        return jax.random.normal(k, shape, f32) * (scale * fan_in ** -0.5)

    def noise(k, shape, scale):
        return jax.random.normal(k, shape, f32) * scale

    n_mod = 3 * N_SUBLAYERS
    return {
        "x": jax.random.normal(ks[0], (BATCH, SEQ, D_MODEL), f32),
        "c": jax.random.normal(ks[1], (BATCH, D_MODEL), f32),
        "ctx": jax.random.normal(ks[2], (BATCH, CTX_LEN, D_MODEL), f32),
        "c_ctx": jax.random.normal(ks[3], (D_MODEL,), f32),
        "w_ada": w(ks[4], (DEPTH, D_MODEL, n_mod * D_MODEL), D_MODEL, 0.5),
        "b_ada": noise(ks[5], (DEPTH, n_mod * D_MODEL), 0.02),
        "ln_gain": 1.0 + noise(ks[6], (DEPTH, N_SUBLAYERS, D_MODEL), 0.05),
        "ln_bias": noise(ks[7], (DEPTH, N_SUBLAYERS, D_MODEL), 0.02),
        "ffn1_w_in": w(ks[8], (DEPTH, D_MODEL, 2 * D_FF), D_MODEL),
        "ffn1_w_out": w(ks[9], (DEPTH, D_FF, D_MODEL), D_FF, DN_BETA),
        "w_mix_in": w(ks[10], (DEPTH, D_MODEL, IN_WIDTH), D_MODEL),
        "gla_a2_fwd": w(ks[11], (DEPTH, GLA_GATE_RANK, GLA_QK), GLA_GATE_RANK),
        "gla_a2_bwd": w(ks[12], (DEPTH, GLA_GATE_RANK, GLA_QK), GLA_GATE_RANK),
        "gla_a_bias_fwd": noise(ks[13], (DEPTH, GLA_QK), 0.1),
        "gla_a_bias_bwd": noise(ks[14], (DEPTH, GLA_QK), 0.1),
        "hgrn_lb_logits": noise(ks[15], (2, DEPTH + 1, HGRN_K), 0.1),
        "gla_norm_gain": 1.0 + noise(ks[16], (DEPTH, GLA_DV), 0.05),
        "hgrn_norm_gain": 1.0 + noise(ks[17], (DEPTH, HGRN_DV), 0.05),
        "w_mix_out": w(ks[18], (DEPTH, MIX_WIDTH, D_MODEL), MIX_WIDTH, DN_BETA),
        "ffn2_w_in": w(ks[19], (DEPTH, D_MODEL, 2 * D_FF), D_MODEL),
        "ffn2_w_out": w(ks[20], (DEPTH, D_FF, D_MODEL), D_FF, DN_BETA),
    }


def reference(x, c, ctx, c_ctx, w_ada, b_ada, ln_gain, ln_bias, ffn1_w_in, ffn1_w_out, w_mix_in,
              gla_a2_fwd, gla_a2_bwd, gla_a_bias_fwd, gla_a_bias_bwd, hgrn_lb_logits,
              gla_norm_gain, hgrn_norm_gain, w_mix_out, ffn2_w_in, ffn2_w_out):
    bsz, n_tok, d = x.shape
    rows = n_tok // GRID_W
    x = x + sincos_2d(rows, GRID_W, d).astype(x.dtype)[None]
    xc = ctx
    lb = jnp.cumsum(jax.nn.softmax(hgrn_lb_logits.astype(jnp.float32), axis=1), axis=1)
    n_mod = 3 * N_SUBLAYERS
    for l in range(DEPTH):
        m = (jax.nn.silu(c) @ w_ada[l] + b_ada[l]).reshape(bsz, n_mod, d)
        mc = (jax.nn.silu(c_ctx) @ w_ada[l] + b_ada[l]).reshape(1, n_mod, d)
        x, xc = trunk_layer(x, xc, m, mc, l < DEPTH - 1, ln_gain[l], ln_bias[l], ffn1_w_in[l], ffn1_w_out[l], w_mix_in[l],
                            gla_a2_fwd[l], gla_a2_bwd[l], gla_a_bias_fwd[l], gla_a_bias_bwd[l], lb[0, l], lb[1, l],
                            gla_norm_gain[l], hgrn_norm_gain[l], w_mix_out[l], ffn2_w_in[l], ffn2_w_out[l])
    return x
```

```cpp
#include <hip/hip_runtime.h>
#include <hip/hip_cooperative_groups.h>
#include <cstdio>
#include <cstdint>
namespace cg = cooperative_groups;
namespace pg8 {
#define PG8_LAS __attribute__((address_space(3)))
typedef unsigned short bf16_t;
typedef short bf16x8 __attribute__((ext_vector_type(8)));
typedef float f32x4 __attribute__((ext_vector_type(4)));
typedef unsigned u32x4 __attribute__((ext_vector_type(4)));
constexpr int BM = 256, BK = 64, HALF = 128, HTB = HALF * BK * 2  , STAGE_BYTES = 8 * HTB, NXCD = 8, WGM = 8;

__host__ __device__ __forceinline__ int lds_byte(int r, int c) { const int st = (r >> 4) * 2 + (c >> 5), rr = r & 15, cc = c & 31, ob = rr * 64 + cc * 2; return st * 1024 + (ob ^ (((ob >> 9) & 1) << 5)); }
__host__ __device__ __forceinline__ void stage_rc(int b, int& R, int& C) { const int st = b / 1024, sb = b % 1024, swz = sb ^ (((sb >> 9) & 1) << 5); R = (st >> 1) * 16 + swz / 64; C = (st & 1) * 32 + (swz % 64) / 2; }
__host__ __device__ __forceinline__ int perm32(int rho) { const int n = rho >> 4, i = rho & 15; return 8 * (i >> 2) + 4 * n + (i & 3); }

struct Unit { int pm, pn; };
struct Gemm { const bf16_t* A; const bf16_t* Bt; int M, N, K; };

struct StaticOrder {
    int nM, nN, nwg, G, c;
    __host__ __device__ void init(int M, int N, int G_, int c_) { nM = M / BM; nN = N / BM; nwg = nM * nN; G = G_; c = c_; }
    __host__ __device__ bool next(int i, Unit& u) const {
        const long L = (long)i * G + c; if (L >= nwg) return false;
        int wgid = (int)L; { const int q = nwg / NXCD, r = nwg % NXCD, xcd = wgid % NXCD, off = wgid / NXCD; wgid = (xcd < r ? xcd * (q + 1) : r * (q + 1) + (xcd - r) * q) + off; }
        const int nig = WGM * nN, gid = wgid / nig, fm = gid * WGM, gsz = (nM - fm) < WGM ? (nM - fm) : WGM;
        u.pm = fm + ((wgid % nig) % gsz); u.pn = (wgid % nig) / gsz; return true;
    }
    __device__ __forceinline__ void a_ready(const Unit&) const {}
    __device__ __forceinline__ void done(const Unit&) const {}
};

__device__ __forceinline__ unsigned cvt_pk_bf16(float lo, float hi) { unsigned r; asm volatile("v_cvt_pk_bf16_f32 %0, %1, %2" : "=v"(r) : "v"(lo), "v"(hi)); return r; }
typedef float f32x2 __attribute__((ext_vector_type(2)));
__device__ __forceinline__ float silu_f(float g) { return g * __builtin_amdgcn_rcpf(1.0f + __builtin_amdgcn_exp2f(-1.44269504089f * g)); }
struct EpiBf16Plain {
    static constexpr bool PERM = true, AFTER_DRAIN = false;
    bf16_t* O; int ldc;
    __device__ __forceinline__ void operator()(const f32x4 (&acc)[2][2][4][2], const Unit& u, int wr, int wc, int fr, int fq) const {
        const int row0 = u.pm * BM + wr * 64 + fr; const int col0 = u.pn * BM + wc * 32 + 8 * fq;
#pragma unroll
        for (int ai = 0; ai < 2; ++ai)
#pragma unroll
            for (int m = 0; m < 4; ++m) { bf16_t* rowp = O + (size_t)(row0 + ai * HALF + m * 16) * ldc + col0;
#pragma unroll
                for (int bj = 0; bj < 2; ++bj) { const f32x4 v0 = acc[ai][bj][m][0], v1 = acc[ai][bj][m][1];
                    u32x4 w; w.x = cvt_pk_bf16(v0[0], v0[1]); w.y = cvt_pk_bf16(v0[2], v0[3]); w.z = cvt_pk_bf16(v1[0], v1[1]); w.w = cvt_pk_bf16(v1[2], v1[3]);
                    *(u32x4*)(rowp + bj * HALF) = w; } }
    }
};
struct EpiSwiGLU {
    static constexpr bool PERM = true, AFTER_DRAIN = false;
    bf16_t* O; int ldc;
    __device__ __forceinline__ void operator()(const f32x4 (&acc)[2][2][4][2], const Unit& u, int wr, int wc, int fr, int fq) const {
        const int row0 = u.pm * BM + wr * 64 + fr; const int col0 = u.pn * HALF + wc * 32 + 8 * fq;
#pragma unroll
        for (int ai = 0; ai < 2; ++ai)
#pragma unroll
            for (int m = 0; m < 4; ++m) { bf16_t* rowp = O + (size_t)(row0 + ai * HALF + m * 16) * ldc + col0;
                const f32x4 g0 = acc[ai][0][m][0], g1 = acc[ai][0][m][1], u0 = acc[ai][1][m][0], u1 = acc[ai][1][m][1];
                u32x4 w;
                w.x = cvt_pk_bf16(silu_f(g0[0]) * u0[0], silu_f(g0[1]) * u0[1]); w.y = cvt_pk_bf16(silu_f(g0[2]) * u0[2], silu_f(g0[3]) * u0[3]);
                w.z = cvt_pk_bf16(silu_f(g1[0]) * u1[0], silu_f(g1[1]) * u1[1]); w.w = cvt_pk_bf16(silu_f(g1[2]) * u1[2], silu_f(g1[3]) * u1[3]);
                *(u32x4*)rowp = w; }
    }
};
struct EpiResid {
    static constexpr bool PERM = false, AFTER_DRAIN = false;
    float* Xlat; float* Xctx; const float* mtab; int gate_idx; float w; float alpha;
    __device__ __forceinline__ void operator()(const f32x4 (&acc)[2][2][4][2], const Unit& u, int wr, int wc, int fr, int fq) const {
        const bool lat = u.pm < 256; const int b = lat ? (u.pm >> 3) : 32;
        const float* g = mtab + ((size_t)b * 9 + gate_idx) * 1024;
        float* X = lat ? Xlat + (size_t)u.pm * BM * 1024 : Xctx + (size_t)(u.pm - 256) * BM * 1024;
        const int col0 = u.pn * BM + wc * 32 + 4 * fq;
#pragma unroll
        for (int bj = 0; bj < 2; ++bj)
#pragma unroll
            for (int n = 0; n < 2; ++n) { const int col = col0 + bj * HALF + n * 16; f32x4 gv = *(const f32x4*)(g + col); gv = gv * w;
#pragma unroll
                for (int ai = 0; ai < 2; ++ai)
#pragma unroll
                    for (int m = 0; m < 4; ++m) { float* p = X + (size_t)(ai * HALF + wr * 64 + m * 16 + fr) * 1024 + col;
                        const f32x4 xv = *(const f32x4*)p; *(f32x4*)p = xv * alpha + gv * acc[ai][bj][m][n]; } }
    }
};
template <class Epi, class Sched, bool ALIGN_EPI = false, bool SP2 = false>
__device__ __forceinline__ void gemm_phase(PG8_LAS unsigned char* lds, const Gemm g, const Sched& S, const Epi& E) {
    const int tid = threadIdx.x, wid = __builtin_amdgcn_readfirstlane(tid >> 6), lane = tid & 63, wr = wid >> 2, wc = wid & 3, fr = lane & 15, fq = lane >> 4;
    const int K = g.K, nt = K / BK;
    unsigned voffA[2], voffB[2];
#pragma unroll
    for (int i = 0; i < 2; ++i) { int R, C; stage_rc(tid * 16 + i * 8192, R, C); const int Rb = Epi::PERM ? ((R & ~31) + perm32(R & 31)) : R;
        voffA[i] = (unsigned)(R * K + C) * 2u; voffB[i] = (unsigned)(Rb * K + C) * 2u; }
    const size_t kstep = (size_t)(BK * 2);
    const size_t hstep = (size_t)HALF * K * 2;
    const size_t tstep = 2 * hstep;
    const unsigned ldsw = (unsigned)wid * 1024u;
    const int aoff = lds_byte(wr * 64 + fr, fq * 8), boff = lds_byte(wc * 32 + fr, fq * 8);
#define PG8_SA(b, h) (((b) * 2 + (h)) * HTB)
#define PG8_SB(b, h) ((4 + (b) * 2 + (h)) * HTB)
#define PG8_STAGE(bufoff, gbase, voff) do { _Pragma("unroll") for (int _i = 0; _i < 2; ++_i) \
        __builtin_amdgcn_global_load_lds((const unsigned*)((const char*)(gbase) + (voff)[_i]), (PG8_LAS unsigned*)(lds + (bufoff) + ldsw + _i * 8192), 16, 0, 0); } while (0)
#define PG8_LDA(dst, b, h) do { _Pragma("unroll") for (int m = 0; m < 4; ++m) _Pragma("unroll") for (int k = 0; k < 2; ++k) dst[m][k] = *(const PG8_LAS bf16x8*)(lds + PG8_SA(b, h) + aoff + m * 2048 + k * 1024); } while (0)
#define PG8_LDB(dst, b, h) do { _Pragma("unroll") for (int n = 0; n < 2; ++n) _Pragma("unroll") for (int k = 0; k < 2; ++k) dst[n][k] = *(const PG8_LAS bf16x8*)(lds + PG8_SB(b, h) + boff + n * 2048 + k * 1024); } while (0)
#define PG8_MMA(ai, bj, At, Bt) do { __builtin_amdgcn_s_setprio(1); _Pragma("unroll") for (int m = 0; m < 4; ++m) _Pragma("unroll") for (int n = 0; n < 2; ++n) _Pragma("unroll") for (int k = 0; k < 2; ++k) \
        acc[ai][bj][m][n] = __builtin_amdgcn_mfma_f32_16x16x32_bf16(Bt[n][k], At[m][k], acc[ai][bj][m][n], 0, 0, 0); __builtin_amdgcn_s_setprio(0); } while (0)
#define PG8_WAIT_V(n) asm volatile("s_waitcnt vmcnt(" #n ")" ::: "memory")
#define PG8_WAIT_L(n) asm volatile("s_waitcnt lgkmcnt(" #n ")" ::: "memory")
#define PG8_BAR __builtin_amdgcn_s_barrier()
#define PG8_SCHED __builtin_amdgcn_sched_barrier(0)
    Unit cur, nxt; int ui = 0;
    if (!S.next(0, cur)) return;
    f32x4 acc[2][2][4][2];
#pragma unroll
    for (int a = 0; a < 2; ++a)
#pragma unroll
        for (int b = 0; b < 2; ++b)
#pragma unroll
            for (int m = 0; m < 4; ++m)
#pragma unroll
                for (int n = 0; n < 2; ++n) acc[a][b][m][n] = (f32x4){0.f, 0.f, 0.f, 0.f};
    bf16x8 At[4][2], B0[2][2], B1[2][2];
    const char* cA = (const char*)g.A + (size_t)cur.pm * tstep; const char* cB = (const char*)g.Bt + (size_t)cur.pn * tstep;
    S.a_ready(cur);
    if constexpr (SP2) {
        PG8_STAGE(PG8_SB(0, 0), cB, voffB); PG8_STAGE(PG8_SB(0, 1), cB + hstep, voffB); PG8_STAGE(PG8_SA(0, 0), cA, voffA); PG8_STAGE(PG8_SA(0, 1), cA + hstep, voffA);
        if (wr == 1) PG8_BAR;
        PG8_WAIT_V(2); PG8_BAR;
        PG8_STAGE(PG8_SB(1, 0), cB + kstep, voffB); PG8_STAGE(PG8_SA(1, 0), cA + kstep, voffA); PG8_STAGE(PG8_SB(1, 1), cB + hstep + kstep, voffB);
        PG8_WAIT_V(6); PG8_BAR;
    } else {
        PG8_STAGE(PG8_SB(0, 0), cB, voffB); PG8_STAGE(PG8_SA(0, 0), cA, voffA); PG8_STAGE(PG8_SB(0, 1), cB + hstep, voffB); PG8_STAGE(PG8_SA(0, 1), cA + hstep, voffA);
        if (wr == 1) PG8_BAR;
        PG8_WAIT_V(4); PG8_BAR;
        PG8_STAGE(PG8_SB(1, 0), cB + kstep, voffB); PG8_STAGE(PG8_SA(1, 0), cA + kstep, voffA); PG8_STAGE(PG8_SB(1, 1), cB + hstep + kstep, voffB);
        PG8_WAIT_V(6); PG8_BAR;
    }
    for (;;) {
        const bool has_next = S.next(ui + 1, nxt);
        const char* nA = has_next ? (const char*)g.A + (size_t)nxt.pm * tstep : cA; const char* nB = has_next ? (const char*)g.Bt + (size_t)nxt.pn * tstep : cB;
        for (int t = 0; t < nt; t += 2) {
            const bool last = (t == nt - 2);
            const char* a1 = cA + (size_t)(t + 1) * kstep;
            const char* a2 = last ? nA : cA + (size_t)(t + 2) * kstep; const char* b2 = last ? nB : cB + (size_t)(t + 2) * kstep;
            const char* a3 = a2 + kstep; const char* b3 = b2 + kstep;
            if (last && has_next) S.a_ready(nxt);
            if constexpr (SP2) {
            PG8_LDB(B0, 0, 0); PG8_LDB(B1, 0, 1); PG8_SCHED; PG8_LDA(At, 0, 0); PG8_STAGE(PG8_SA(1, 1), a1 + hstep, voffA);
            PG8_WAIT_V(8); PG8_WAIT_L(0); PG8_BAR; PG8_MMA(0, 0, At, B0); PG8_MMA(0, 1, At, B1); PG8_BAR; PG8_SCHED;
            PG8_LDA(At, 0, 1); PG8_STAGE(PG8_SB(0, 0), b2, voffB); PG8_STAGE(PG8_SB(0, 1), b2 + hstep, voffB); PG8_STAGE(PG8_SA(0, 0), a2, voffA);
            PG8_WAIT_V(8); PG8_WAIT_L(0); PG8_BAR; PG8_MMA(1, 0, At, B0); PG8_MMA(1, 1, At, B1); PG8_BAR; PG8_SCHED;
            PG8_LDB(B0, 1, 0); PG8_LDB(B1, 1, 1); PG8_SCHED; PG8_LDA(At, 1, 0); PG8_STAGE(PG8_SA(0, 1), a2 + hstep, voffA);
            PG8_WAIT_V(8); PG8_WAIT_L(0); PG8_BAR; PG8_MMA(0, 0, At, B0); PG8_MMA(0, 1, At, B1); PG8_BAR; PG8_SCHED;
            PG8_LDA(At, 1, 1); PG8_STAGE(PG8_SB(1, 0), b3, voffB); PG8_STAGE(PG8_SB(1, 1), b3 + hstep, voffB); PG8_STAGE(PG8_SA(1, 0), a3, voffA);
            PG8_WAIT_V(8); PG8_WAIT_L(0); PG8_BAR; PG8_MMA(1, 0, At, B0); PG8_MMA(1, 1, At, B1); PG8_BAR; PG8_SCHED;
            } else {
            PG8_LDB(B0, 0, 0); PG8_SCHED; PG8_LDA(At, 0, 0); PG8_STAGE(PG8_SA(1, 1), a1 + hstep, voffA);
            PG8_WAIT_L(8); PG8_BAR; PG8_WAIT_L(0); PG8_MMA(0, 0, At, B0); PG8_BAR; PG8_SCHED;
            PG8_LDB(B1, 0, 1); PG8_STAGE(PG8_SB(0, 0), b2, voffB);
            PG8_BAR; PG8_WAIT_L(0); PG8_MMA(0, 1, At, B1); PG8_BAR;
            PG8_LDA(At, 0, 1); PG8_STAGE(PG8_SA(0, 0), a2, voffA);
            PG8_BAR; PG8_WAIT_L(0); PG8_MMA(1, 0, At, B0); PG8_BAR; PG8_SCHED;
            PG8_STAGE(PG8_SB(0, 1), b2 + hstep, voffB);
            PG8_WAIT_V(6); PG8_BAR; PG8_MMA(1, 1, At, B1); PG8_BAR;
            PG8_LDB(B0, 1, 0); PG8_SCHED; PG8_LDA(At, 1, 0); PG8_STAGE(PG8_SA(0, 1), a2 + hstep, voffA);
            PG8_WAIT_L(8); PG8_BAR; PG8_WAIT_L(0); PG8_MMA(0, 0, At, B0); PG8_BAR; PG8_SCHED;
            PG8_LDB(B1, 1, 1); PG8_STAGE(PG8_SB(1, 0), b3, voffB);
            PG8_BAR; PG8_WAIT_L(0); PG8_MMA(0, 1, At, B1); PG8_BAR;
            PG8_LDA(At, 1, 1); PG8_STAGE(PG8_SA(1, 0), a3, voffA);
            PG8_BAR; PG8_WAIT_L(0); PG8_MMA(1, 0, At, B0); PG8_BAR; PG8_SCHED;
            PG8_STAGE(PG8_SB(1, 1), b3 + hstep, voffB);
            PG8_WAIT_V(6); PG8_BAR; PG8_MMA(1, 1, At, B1); PG8_BAR;
            }
        }
        if constexpr (ALIGN_EPI) { if (wr == 0) PG8_BAR; }
        if constexpr (!Epi::AFTER_DRAIN) { E(acc, cur, wr, wc, fr, fq); S.done(cur); }
        if (!has_next) break;
#pragma unroll
        for (int a = 0; a < 2; ++a)
#pragma unroll
            for (int b = 0; b < 2; ++b)
#pragma unroll
                for (int m = 0; m < 4; ++m)
#pragma unroll
                    for (int n = 0; n < 2; ++n) acc[a][b][m][n] = (f32x4){0.f, 0.f, 0.f, 0.f};
        cur = nxt; cA = nA; cB = nB; ++ui;
        if constexpr (ALIGN_EPI) { if (wr == 1) PG8_BAR; }
    }
    PG8_WAIT_V(0);
    if constexpr (!ALIGN_EPI) { if (wr == 0) PG8_BAR; }
    PG8_BAR;
    if constexpr (Epi::AFTER_DRAIN) { E.fused(acc, cur, wr, wc, fr, fq, lds, wid, lane); S.done(cur); }
#undef PG8_SA
#undef PG8_SB
#undef PG8_STAGE
#undef PG8_LDA
#undef PG8_LDB
#undef PG8_MMA
#undef PG8_WAIT_V
#undef PG8_WAIT_L
#undef PG8_BAR
#undef PG8_SCHED
}
}

#define LAS __attribute__((address_space(3)))
typedef unsigned short bf16;
typedef float f32x4 __attribute__((ext_vector_type(4)));
typedef float f32x16 __attribute__((ext_vector_type(16)));
typedef short bf16x8 __attribute__((ext_vector_type(8)));
typedef short s16x4 __attribute__((ext_vector_type(4)));
typedef unsigned u32x4 __attribute__((ext_vector_type(4)));
typedef unsigned u32x2 __attribute__((ext_vector_type(2)));

constexpr int D = 1024, NB = 32, T = 2048, TC = 256, DFF = 2816;
constexpr int MLAT = NB * T, MCTX = NB * TC, MALL = MLAT + MCTX;
constexpr int FW = 4352;
constexpr int GQ = 0, GK = 256, GV = 512, GG = 1024, HQ = 1536, HFF = 2048, HFB = 2560, HI = 3072, HG = 3584, LRF = 4096, LRB = 4112;
constexpr float LN_EPS = 1e-5f, NORM_EPS = 1e-6f;
constexpr float DN_ALPHA = 1.189207115002721f;
constexpr size_t MiB = 1u << 20;
constexpr size_t WS_M = 0, WS_TAB = 2 * MiB, WS_W1IN = 3 * MiB, WS_W1OUT = 14 * MiB, WS_WMIX = 20 * MiB, WS_WMO = 29 * MiB, WS_W2IN = 31 * MiB, WS_W2OUT = 42 * MiB,
                 WS_XC = 48 * MiB, WS_H = 80 * MiB, WS_OB = 224 * MiB, WS_FEAT = 352 * MiB, WS_END = 964 * MiB;
constexpr int LDS_BYTES = 147456;

struct Args {
    const float *x, *c, *ctx, *c_ctx, *w_ada, *b_ada, *ln_gain, *ln_bias, *ffn1_w_in, *ffn1_w_out, *w_mix_in, *a2_f, *a2_b, *abias_f, *abias_b, *lb_logits,
                *gla_gain, *hgrn_gain, *w_mix_out, *ffn2_w_in, *ffn2_w_out;
    float* out; unsigned char* ws; int ph_lo, ph_hi;
};

__device__ __forceinline__ unsigned f2bf(float f) { unsigned u = __builtin_bit_cast(unsigned, f); return (u + 0x7fffu + ((u >> 16) & 1u)) >> 16; }
__device__ __forceinline__ unsigned pk2(float lo, float hi) { return f2bf(lo) | (f2bf(hi) << 16); }
__device__ __forceinline__ float bf2f(unsigned short v) { return __builtin_bit_cast(float, (unsigned)v << 16); }
__device__ __forceinline__ float wave_sum(float v) {
#pragma unroll
    for (int o = 1; o < 64; o <<= 1) v += __shfl_xor(v, o);
    return v;
}
#define LDS_WAIT() asm volatile("s_waitcnt lgkmcnt(0)" ::: "memory")

__device__ __forceinline__ int remap_row(int kind, int n) {
    if (kind == 1) { const int half = n >= DFF ? 1 : 0, j = n - half * DFF; return 256 * (j >> 7) + 128 * half + (j & 127); }
    if (kind == 2) { return n < 1536 ? n : (n < 1568 ? 4096 + (n - 1536) : n - 32); }
    return n;
}
__device__ __forceinline__ void p0_transpose_item(const float* W, int K, int N, bf16* WT, int kind, LAS float* scr, int item, int lane) {
    const int nblk = N / 32, kb = item / nblk, nb = item % nblk, k0 = 64 * kb, n0 = 32 * nb;
    const int r0 = remap_row(kind, n0);
#pragma unroll 8
    for (int i = 0; i < 32; ++i) { const int kk = 2 * i + (lane >> 5); scr[kk * 33 + (lane & 31)] = W[(size_t)(k0 + kk) * N + n0 + (lane & 31)]; }
    LDS_WAIT(); asm volatile("" ::: "memory");
    const int c = lane & 7;
#pragma unroll
    for (int j = 0; j < 4; ++j) { const int n = (lane >> 3) + 8 * j; const LAS float* s = scr + (8 * c) * 33 + n;
        u32x4 o; o.x = pk2(s[0 * 33], s[1 * 33]); o.y = pk2(s[2 * 33], s[3 * 33]); o.z = pk2(s[4 * 33], s[5 * 33]); o.w = pk2(s[6 * 33], s[7 * 33]);
        *(u32x4*)(WT + (size_t)(r0 + n) * K + k0 + 8 * c) = o; }
    LDS_WAIT(); asm volatile("" ::: "memory");
}
__device__ __forceinline__ void p0_prologue(const Args& a, LAS unsigned char* lds) {
    const int tid = threadIdx.x, lane = tid & 63, wave = tid >> 6;
    const int G = gridDim.x, gw = blockIdx.x * 8 + wave, NGW = G * 8;
    unsigned char* ws = a.ws;
    {
        LAS float* scr = (LAS float*)(lds + wave * 16384);
        constexpr int I_IN = (D / 64) * (2 * DFF / 32), I_OUT = (DFF / 64) * (D / 32), I_MIX = (D / 64) * (4128 / 32), I_MO = (D / 64) * (D / 32);
        constexpr int NITEMS = 2 * I_IN + 2 * I_OUT + I_MIX + I_MO;
        for (int it = gw; it < NITEMS; it += NGW) {
            int r = it;
            if (r < I_IN) { p0_transpose_item(a.ffn1_w_in, D, 2 * DFF, (bf16*)(ws + WS_W1IN), 1, scr, r, lane); continue; } r -= I_IN;
            if (r < I_IN) { p0_transpose_item(a.ffn2_w_in, D, 2 * DFF, (bf16*)(ws + WS_W2IN), 1, scr, r, lane); continue; } r -= I_IN;
            if (r < I_OUT) { p0_transpose_item(a.ffn1_w_out, DFF, D, (bf16*)(ws + WS_W1OUT), 0, scr, r, lane); continue; } r -= I_OUT;
            if (r < I_OUT) { p0_transpose_item(a.ffn2_w_out, DFF, D, (bf16*)(ws + WS_W2OUT), 0, scr, r, lane); continue; } r -= I_OUT;
            if (r < I_MIX) { p0_transpose_item(a.w_mix_in, D, 4128, (bf16*)(ws + WS_WMIX), 2, scr, r, lane); continue; } r -= I_MIX;
            p0_transpose_item(a.w_mix_out, D, D, (bf16*)(ws + WS_WMO), 0, scr, r, lane);
        }
        u32x4* z = (u32x4*)((bf16*)(ws + WS_WMIX) + (size_t)4128 * D);
        for (int i = blockIdx.x * 512 + tid; i < 224 * D / 8; i += G * 512) z[i] = (u32x4){0u, 0u, 0u, 0u};
        float* tab = (float*)(ws + WS_TAB);
        for (int i = blockIdx.x * 512 + tid; i < 64 * 256; i += G * 512) { const int p = i >> 8, q = i & 255;
            const float omega = 1.0f / powf(10000.0f, (float)q * (1.0f / 256.0f)); const float ang = (float)p * omega;
            tab[p * 512 + q] = sinf(ang); tab[p * 512 + 256 + q] = cosf(ang); }
    }
    __syncthreads();
    for (int item = blockIdx.x; item < 9216 / 64; item += G) {
        LAS float* sc = (LAS float*)lds;
        for (int i = tid; i < 33 * 1024; i += 512) { const float v = i < 32 * 1024 ? a.c[i] : a.c_ctx[i - 32 * 1024]; sc[i] = v / (1.0f + __expf(-v)); }
        __syncthreads();
        float acc[33];
#pragma unroll
        for (int b = 0; b < 33; ++b) acc[b] = 0.f;
        const int n = item * 64 + lane;
        for (int k = wave * 128; k < wave * 128 + 128; ++k) { const float wv = a.w_ada[(size_t)k * 9216 + n];
#pragma unroll
            for (int b = 0; b < 33; ++b) acc[b] += sc[b * 1024 + k] * wv; }
        __syncthreads();
        LAS float* red = (LAS float*)lds;
#pragma unroll
        for (int b = 0; b < 33; ++b) red[(wave * 33 + b) * 64 + lane] = acc[b];
        __syncthreads();
        float* mt = (float*)(ws + WS_M);
        for (int i = tid; i < 33 * 64; i += 512) { const int b = i >> 6, l = i & 63; float s = 0.f;
#pragma unroll
            for (int w = 0; w < 8; ++w) s += red[(w * 33 + b) * 64 + l];
            mt[(size_t)b * 9216 + item * 64 + l] = s + a.b_ada[item * 64 + l]; }
        __syncthreads();
    }
}

template <int MODE>
__device__ __forceinline__ void ln_pass(const Args& a, int sub, int li, int nrows) {
    const int tid = threadIdx.x, lane = tid & 63, wave = tid >> 6;
    const int gw = blockIdx.x * 8 + wave, NGW = gridDim.x * 8;
    const float* mt = (const float*)(a.ws + WS_M);
    const float* tab = (const float*)(a.ws + WS_TAB);
    float* xc = (float*)(a.ws + WS_XC);
    bf16* H = (bf16*)(a.ws + WS_H);
    for (int r = gw; r < nrows; r += NGW) {
        const bool lat = r < MLAT; const int b = lat ? (r >> 11) : 32;
        float* Xrow = lat ? a.out + (size_t)r * D : xc + (size_t)(r - MLAT) * D;
        f32x4 v[4];
        if (MODE == 0) {
            const float* src = lat ? a.x + (size_t)r * D : a.ctx + (size_t)(r - MLAT) * D;
#pragma unroll
            for (int j = 0; j < 4; ++j) v[j] = *((const f32x4*)src + lane + 64 * j);
            if (lat) { const int t = r & 2047; const float* tr = tab + (t >> 6) * 512; const float* tcl = tab + (t & 63) * 512;
                v[0] += *((const f32x4*)tr + lane); v[1] += *((const f32x4*)tr + lane + 64); v[2] += *((const f32x4*)tcl + lane); v[3] += *((const f32x4*)tcl + lane + 64); }
#pragma unroll
            for (int j = 0; j < 4; ++j) *((f32x4*)Xrow + lane + 64 * j) = v[j];
        } else {
            float s = 0.f;
#pragma unroll
            for (int j = 0; j < 4; ++j) { v[j] = *((const f32x4*)Xrow + lane + 64 * j); s += (v[j].x + v[j].y) + (v[j].z + v[j].w); }
            const float mean = wave_sum(s) * (1.f / D); float s2 = 0.f;
#pragma unroll
            for (int j = 0; j < 4; ++j) { v[j] = v[j] - mean; s2 += (v[j].x * v[j].x + v[j].y * v[j].y) + (v[j].z * v[j].z + v[j].w * v[j].w); }
            const float rstd = 1.f / sqrtf(wave_sum(s2) * (1.f / D) + LN_EPS);
            const float* gn = a.ln_gain + li * D; const float* bs = a.ln_bias + li * D;
#pragma unroll
            for (int j = 0; j < 4; ++j) { const f32x4 g4 = *((const f32x4*)gn + lane + 64 * j), b4 = *((const f32x4*)bs + lane + 64 * j); v[j] = v[j] * rstd * g4 + b4; *((f32x4*)Xrow + lane + 64 * j) = v[j]; }
        }
        if (MODE != 2) {
            float s = 0.f;
#pragma unroll
            for (int j = 0; j < 4; ++j) s += (v[j].x + v[j].y) + (v[j].z + v[j].w);
            const float mean = wave_sum(s) * (1.f / D); float s2 = 0.f;
#pragma unroll
            for (int j = 0; j < 4; ++j) { v[j] = v[j] - mean; s2 += (v[j].x * v[j].x + v[j].y * v[j].y) + (v[j].z * v[j].z + v[j].w * v[j].w); }
            const float rstd = 1.f / sqrtf(wave_sum(s2) * (1.f / D) + LN_EPS);
            const float* m0 = mt + ((size_t)b * 9 + 3 * sub) * D; const float* m1 = m0 + D;
            u32x2* o8 = (u32x2*)(H + (size_t)r * D) + lane;
#pragma unroll
            for (int j = 0; j < 4; ++j) { const f32x4 s4 = *((const f32x4*)m0 + lane + 64 * j), t4 = *((const f32x4*)m1 + lane + 64 * j);
                const f32x4 h = v[j] * rstd * (s4 + 1.0f) + t4; u32x2 w; w.x = pk2(h.x, h.y); w.y = pk2(h.z, h.w); o8[64 * j] = w; }
        }
    }
}
__device__ __forceinline__ float silu_q(float g) { return g * __builtin_amdgcn_rcpf(1.0f + __expf(-g)); }

#define MFMA32(a_, b_, c_) __builtin_amdgcn_mfma_f32_32x32x16_bf16((a_), (b_), (c_), 0, 0, 0)
typedef float f32x2_t __attribute__((ext_vector_type(2)));
typedef __bf16 bf16x2_t __attribute__((ext_vector_type(2)));
__device__ __forceinline__ unsigned cvtpk(float lo, float hi) { f32x2_t v = {lo, hi}; bf16x2_t b = __builtin_convertvector(v, bf16x2_t); return __builtin_bit_cast(unsigned, b); }
__device__ __forceinline__ bf16x8 pack8(const f32x16& x, int s) {
    u32x4 p; p.x = cvtpk(x[8 * s], x[8 * s + 1]); p.y = cvtpk(x[8 * s + 2], x[8 * s + 3]); p.z = cvtpk(x[8 * s + 4], x[8 * s + 5]); p.w = cvtpk(x[8 * s + 6], x[8 * s + 7]);
    return __builtin_bit_cast(bf16x8, p);
}
__device__ __forceinline__ int scan_base(int s, int dir, int b) {
    if (s < 8) return MLAT + b * TC + 32 * (dir ? 7 - s : s);
    return b * T + 32 * (dir ? 63 - (s - 8) : s - 8);
}
template <int DK>
__device__ __forceinline__ void scan_item(const Args& a, LAS unsigned char* lds, const int b, const int head) {
    constexpr bool HGR = (DK == 128);
    constexpr int TPT = DK / 8, NG = 32 / TPT, QS = DK + 8, TS = 40;
    constexpr int OFF_QD = 0, OFF_KI = OFF_QD + 32 * QS * 2, OFF_KT = OFF_KI + 32 * QS * 2, OFF_VT = OFF_KT + DK * TS * 2, OFF_DEC = OFF_VT + 128 * TS * 2,
                  OFF_CS = OFF_DEC + DK * 4, OFF_SSQ = OFF_CS + NG * DK * 4, DIRB = 40960;
    static_assert(OFF_SSQ + 512 <= DIRB, "scan LDS map");
    const int tid = threadIdx.x, lane = tid & 63, wave = tid >> 6, dir = wave >> 2, dvq = wave & 3, gt = tid & 255;
    const int l31 = lane & 31, h = lane >> 5;
    LAS unsigned char* L = lds + dir * DIRB;
    LAS bf16* QD = (LAS bf16*)(L + OFF_QD); LAS bf16* KI = (LAS bf16*)(L + OFF_KI); LAS bf16* KT = (LAS bf16*)(L + OFF_KT); LAS bf16* VT = (LAS bf16*)(L + OFF_VT);
    LAS float* DEC = (LAS float*)(L + OFF_DEC); LAS float* CS = (LAS float*)(L + OFF_CS); LAS float* SSQ = (LAS float*)(L + OFF_SSQ);
    const bf16* F = (const bf16*)(a.ws + WS_FEAT);
    bf16* OB = (bf16*)(a.ws + WS_OB); bf16* MG = (bf16*)(a.ws + WS_H);
    const int c = gt % DK, tg = gt / DK;
    const int vn = gt & 127, vth = gt >> 7;
    float lbv = 0.f, abias = 0.f; float a2c[16];
#pragma unroll
    for (int r = 0; r < 16; ++r) a2c[r] = 0.f;
    if (HGR) { const float* lg = a.lb_logits + dir * 1024 + head * 128 + c; lbv = 1.0f / (1.0f + __expf(lg[512] - lg[0])); }
    else { const float* a2 = dir ? a.a2_b : a.a2_f;
#pragma unroll
        for (int r = 0; r < 16; ++r) a2c[r] = a2[r * 256 + head * 64 + c];
        abias = (dir ? a.abias_b : a.abias_f)[head * 64 + c]; }
    const int qcol = HGR ? HQ + head * 128 + c : GQ + head * 64 + c;
    const int kcol = HGR ? (dir ? HFB : HFF) + head * 128 + c : GK + head * 64 + c;
    const int vcol = (HGR ? HI : GV) + head * 128 + vn;
    const int lrcol = dir ? LRB : LRF;
    const int gcol = (HGR ? HG : GG) + head * 128;
    const int mcol = (HGR ? 512 : 0) + head * 128;
    const float* gain = HGR ? a.hgrn_gain : a.gla_gain;
    const float qscale = HGR ? 0.08838834764831845f : 0.125f;

    f32x16 S[DK / 32];
#pragma unroll
    for (int t = 0; t < DK / 32; ++t)
#pragma unroll
        for (int r = 0; r < 16; ++r) S[t][r] = 0.f;

    unsigned short rq[TPT], rk[TPT], rv[16];
#define SCAN_LOAD(s_) do { const int base_ = scan_base((s_), dir, b); \
        _Pragma("unroll") for (int i = 0; i < TPT; ++i) { const int ti = tg * TPT + i; const size_t row = (size_t)(base_ + (dir ? 31 - ti : ti)); \
            rq[i] = F[row * FW + qcol]; rk[i] = F[row * FW + kcol]; } \
        _Pragma("unroll") for (int i = 0; i < 16; ++i) { const int ti = 16 * vth + i; const size_t row = (size_t)(base_ + (dir ? 31 - ti : ti)); rv[i] = F[row * FW + vcol]; } } while (0)
    SCAN_LOAD(0);
    for (int s = 0; s < 72; ++s) {
        const bool is_out = s >= 8, second = s >= 40;
        const int base = scan_base(s, dir, b);
        float bl[TPT], qv[TPT], kv[TPT]; float run = 0.f;
#pragma unroll
        for (int i = 0; i < TPT; ++i) {
            float q = bf2f(rq[i]), g, k;
            if (HGR) { const float zf = bf2f(rk[i]); const float sg = __builtin_amdgcn_rcpf(1.0f + __expf(-zf)); const float f = lbv + (1.0f - lbv) * sg; g = __logf(f); k = 1.0f - f; q = silu_q(q) * qscale; }
            else { float z = abias; const int ti = tg * TPT + i; const size_t row = (size_t)(base + (dir ? 31 - ti : ti));
                u32x4 rl[2]; rl[0] = *(const u32x4*)(F + row * FW + lrcol); rl[1] = *(const u32x4*)(F + row * FW + lrcol + 8);
#pragma unroll
                for (int w = 0; w < 4; ++w) { const unsigned u0 = rl[w >> 1][(w & 1) * 2], u1 = rl[w >> 1][(w & 1) * 2 + 1];
                    z += __builtin_bit_cast(float, u0 << 16) * a2c[4 * w] + __builtin_bit_cast(float, u0 & 0xffff0000u) * a2c[4 * w + 1]
                       + __builtin_bit_cast(float, u1 << 16) * a2c[4 * w + 2] + __builtin_bit_cast(float, u1 & 0xffff0000u) * a2c[4 * w + 3]; }
                g = (fminf(z, 0.f) - __logf(1.0f + __expf(-fabsf(z)))) * 0.0625f; k = bf2f(rk[i]); q = q * qscale; }
            run += g; bl[i] = run; qv[i] = q; kv[i] = k;
        }
        CS[tg * DK + c] = run;
        { u32x4 w0, w1;
          w0.x = rv[0] | ((unsigned)rv[1] << 16); w0.y = rv[2] | ((unsigned)rv[3] << 16); w0.z = rv[4] | ((unsigned)rv[5] << 16); w0.w = rv[6] | ((unsigned)rv[7] << 16);
          w1.x = rv[8] | ((unsigned)rv[9] << 16); w1.y = rv[10] | ((unsigned)rv[11] << 16); w1.z = rv[12] | ((unsigned)rv[13] << 16); w1.w = rv[14] | ((unsigned)rv[15] << 16);
          *(LAS u32x4*)(VT + vn * TS + 16 * vth) = w0; *(LAS u32x4*)(VT + vn * TS + 16 * vth + 8) = w1; }
        __syncthreads();
        float prefix = 0.f, btot = 0.f;
#pragma unroll
        for (int t = 0; t < NG; ++t) { const float v = CS[t * DK + c]; btot += v; if (t < tg) prefix += v; }
        const float dec = __expf(btot);
        unsigned ktp[TPT / 2];
#pragma unroll
        for (int i = 0; i < TPT; i += 2) {
            const float e0 = __expf(prefix + bl[i]), e1 = __expf(prefix + bl[i + 1]);
            const float ki0 = kv[i] * __builtin_amdgcn_rcpf(e0), ki1 = kv[i + 1] * __builtin_amdgcn_rcpf(e1);
            if (is_out) { const int ti = tg * TPT + i;
                QD[ti * QS + c] = (bf16)f2bf(qv[i] * e0); QD[(ti + 1) * QS + c] = (bf16)f2bf(qv[i + 1] * e1);
                KI[ti * QS + c] = (bf16)f2bf(ki0); KI[(ti + 1) * QS + c] = (bf16)f2bf(ki1); }
            ktp[i >> 1] = cvtpk(ki0 * dec, ki1 * dec);
        }
#pragma unroll
        for (int i = 0; i < TPT / 8; ++i) { u32x4 w; w.x = ktp[4 * i]; w.y = ktp[4 * i + 1]; w.z = ktp[4 * i + 2]; w.w = ktp[4 * i + 3]; *(LAS u32x4*)(KT + c * TS + tg * TPT + 8 * i) = w; }
        if (tg == 0) DEC[c] = dec;
        if (s + 1 < 72) SCAN_LOAD(s + 1);
        __syncthreads();
        f32x16 OT;
#pragma unroll
        for (int r = 0; r < 16; ++r) OT[r] = 0.f;
        if (is_out) {
            f32x16 accT;
#pragma unroll
            for (int r = 0; r < 16; ++r) accT[r] = 0.f;
#pragma unroll
            for (int s2 = 0; s2 < DK / 16; ++s2) {
                const bf16x8 ka = *(const LAS bf16x8*)(KI + l31 * QS + 16 * s2 + 8 * h);
                const bf16x8 qb = *(const LAS bf16x8*)(QD + l31 * QS + 16 * s2 + 8 * h);
                accT = MFMA32(ka, qb, accT);
            }
#pragma unroll
            for (int r = 0; r < 16; ++r) { const int j = (r & 3) + 8 * (r >> 2) + 4 * h; if (j > l31) accT[r] = 0.f; }
#pragma unroll
            for (int u = 0; u < 2; ++u) {
                const bf16x8 ab = pack8(accT, u);
                const s16x4 lo = *(const LAS s16x4*)(VT + (32 * dvq + l31) * TS + 16 * u + 4 * h);
                const s16x4 hi = *(const LAS s16x4*)(VT + (32 * dvq + l31) * TS + 16 * u + 8 + 4 * h);
                const bf16x8 va = __builtin_shufflevector(lo, hi, 0, 1, 2, 3, 4, 5, 6, 7);
                OT = MFMA32(va, ab, OT);
            }
#pragma unroll
            for (int t = 0; t < DK / 32; ++t)
#pragma unroll
                for (int u = 0; u < 2; ++u) {
                    const bf16x8 sa = pack8(S[t], u);
                    const s16x4 lo = *(const LAS s16x4*)(QD + l31 * QS + 32 * t + 16 * u + 4 * h);
                    const s16x4 hi = *(const LAS s16x4*)(QD + l31 * QS + 32 * t + 16 * u + 8 + 4 * h);
                    const bf16x8 qb = __builtin_shufflevector(lo, hi, 0, 1, 2, 3, 4, 5, 6, 7);
                    OT = MFMA32(sa, qb, OT);
                }
        }
#pragma unroll
        for (int t = 0; t < DK / 32; ++t) {
#pragma unroll
            for (int g4 = 0; g4 < 4; ++g4) { const f32x4 d4 = *(const LAS f32x4*)(DEC + 32 * t + 8 * g4 + 4 * h);
                S[t][4 * g4] *= d4.x; S[t][4 * g4 + 1] *= d4.y; S[t][4 * g4 + 2] *= d4.z; S[t][4 * g4 + 3] *= d4.w; }
#pragma unroll
            for (int u = 0; u < 2; ++u) {
                const bf16x8 ka = *(const LAS bf16x8*)(KT + (32 * t + l31) * TS + 16 * u + 8 * h);
                const bf16x8 vb = *(const LAS bf16x8*)(VT + (32 * dvq + l31) * TS + 16 * u + 8 * h);
                S[t] = MFMA32(ka, vb, S[t]);
            }
        }
        if (is_out) {
            const size_t row = (size_t)(base + (dir ? 31 - l31 : l31));
            if (!second) {
#pragma unroll
                for (int g4 = 0; g4 < 4; ++g4) { u32x2 w; w.x = cvtpk(OT[4 * g4], OT[4 * g4 + 1]); w.y = cvtpk(OT[4 * g4 + 2], OT[4 * g4 + 3]);
                    *(u32x2*)(OB + row * D + mcol + 32 * dvq + 8 * g4 + 4 * h) = w; }
            } else {
                float ss = 0.f;
#pragma unroll
                for (int g4 = 0; g4 < 4; ++g4) { const u32x2 w = *(const u32x2*)(OB + row * D + mcol + 32 * dvq + 8 * g4 + 4 * h);
                    OT[4 * g4] += __builtin_bit_cast(float, w.x << 16); OT[4 * g4 + 1] += __builtin_bit_cast(float, w.x & 0xffff0000u);
                    OT[4 * g4 + 2] += __builtin_bit_cast(float, w.y << 16); OT[4 * g4 + 3] += __builtin_bit_cast(float, w.y & 0xffff0000u); }
#pragma unroll
                for (int r = 0; r < 16; ++r) ss += OT[r] * OT[r];
                ss += __shfl_xor(ss, 32);
                if (h == 0) SSQ[dvq * 32 + l31] = ss;
                __syncthreads();
                const float tot = (SSQ[l31] + SSQ[32 + l31]) + (SSQ[64 + l31] + SSQ[96 + l31]);
                const float rs = 1.0f / sqrtf(tot * (1.0f / 128.0f) + NORM_EPS);
#pragma unroll
                for (int g4 = 0; g4 < 4; ++g4) { const int vc = 32 * dvq + 8 * g4 + 4 * h;
                    const u32x2 gw = *(const u32x2*)(F + row * FW + gcol + vc); const f32x4 gn = *(const f32x4*)(gain + vc);
                    const float y0 = OT[4 * g4] * rs * gn.x * silu_q(__builtin_bit_cast(float, gw.x << 16)), y1 = OT[4 * g4 + 1] * rs * gn.y * silu_q(__builtin_bit_cast(float, gw.x & 0xffff0000u));
                    const float y2 = OT[4 * g4 + 2] * rs * gn.z * silu_q(__builtin_bit_cast(float, gw.y << 16)), y3 = OT[4 * g4 + 3] * rs * gn.w * silu_q(__builtin_bit_cast(float, gw.y & 0xffff0000u));
                    u32x2 w; w.x = cvtpk(y0, y1); w.y = cvtpk(y2, y3);
                    *(u32x2*)(MG + row * D + mcol + vc) = w; }
            }
        }
        __threadfence();
        __syncthreads();
    }
#undef SCAN_LOAD
}

__global__ void __launch_bounds__(512, 2) mega(Args a) {
    extern __shared__ __attribute__((aligned(16))) unsigned char lds_raw[];
    LAS unsigned char* lds = (LAS unsigned char*)lds_raw;
    cg::grid_group grid = cg::this_grid();
    unsigned char* ws = a.ws;
    const int lo = a.ph_lo, hi = a.ph_hi;
#define IN(k) (lo <= (k) && (k) < hi)
#define SEAM(k) do { if (IN(k) && IN((k) + 1)) grid.sync(); } while (0)
    float* xc = (float*)(ws + WS_XC); const float* mt = (const float*)(ws + WS_M);
    pg8::bf16_t* H = (pg8::bf16_t*)(ws + WS_H); pg8::bf16_t* HID = (pg8::bf16_t*)(ws + WS_FEAT); pg8::bf16_t* FEAT = (pg8::bf16_t*)(ws + WS_FEAT);
    const int G = gridDim.x, cu = blockIdx.x;

    if (IN(0)) p0_prologue(a, lds);
    SEAM(0);
    if (IN(1)) ln_pass<0>(a, 0, 0, MALL);
    SEAM(1);
    if (IN(2)) { pg8::Gemm g{H, (const pg8::bf16_t*)(ws + WS_W1IN), MALL, 2 * DFF, D}; pg8::StaticOrder S; S.init(MALL, 2 * DFF, G, cu);
        pg8::EpiSwiGLU E{HID, DFF}; pg8::gemm_phase<pg8::EpiSwiGLU, pg8::StaticOrder, true, true>(lds, g, S, E); }
    SEAM(2);
    if (IN(3)) { pg8::Gemm g{HID, (const pg8::bf16_t*)(ws + WS_W1OUT), MALL, D, DFF}; pg8::StaticOrder S; S.init(MALL, D, G, cu);
        pg8::EpiResid E{a.out, xc, mt, 2, 0.5f, DN_ALPHA}; pg8::gemm_phase<pg8::EpiResid, pg8::StaticOrder, true, true>(lds, g, S, E); }
    SEAM(3);
    if (IN(4)) ln_pass<1>(a, 1, 0, MALL);
    SEAM(4);
    if (IN(5)) { pg8::Gemm g{H, (const pg8::bf16_t*)(ws + WS_WMIX), MALL, FW, D}; pg8::StaticOrder S; S.init(MALL, FW, G, cu);
        pg8::EpiBf16Plain E{FEAT, FW}; pg8::gemm_phase<pg8::EpiBf16Plain, pg8::StaticOrder, true, true>(lds, g, S, E); }
    SEAM(5);
    if (IN(6)) {
        if (cu < 256) { const int item = cu; const int b = item >> 3, grp = (item >> 2) & 1, head = item & 3;
            if (grp) scan_item<128>(a, lds, b, head); else scan_item<64>(a, lds, b, head); }
    }
    SEAM(6);
    if (IN(7)) { pg8::Gemm g{H, (const pg8::bf16_t*)(ws + WS_WMO), MLAT, D, D}; pg8::StaticOrder S; S.init(MLAT, D, G, cu);
        pg8::EpiResid E{a.out, xc, mt, 5, 1.0f, DN_ALPHA}; pg8::gemm_phase<pg8::EpiResid, pg8::StaticOrder, true, true>(lds, g, S, E); }
    SEAM(7);
    if (IN(8)) ln_pass<1>(a, 2, 1, MLAT);
    SEAM(8);
    if (IN(9)) { pg8::Gemm g{H, (const pg8::bf16_t*)(ws + WS_W2IN), MLAT, 2 * DFF, D}; pg8::StaticOrder S; S.init(MLAT, 2 * DFF, G, cu);
        pg8::EpiSwiGLU E{HID, DFF}; pg8::gemm_phase<pg8::EpiSwiGLU, pg8::StaticOrder, true, true>(lds, g, S, E); }
    SEAM(9);
    if (IN(10)) { pg8::Gemm g{HID, (const pg8::bf16_t*)(ws + WS_W2OUT), MLAT, D, DFF}; pg8::StaticOrder S; S.init(MLAT, D, G, cu);
        pg8::EpiResid E{a.out, xc, mt, 8, 0.5f, DN_ALPHA}; pg8::gemm_phase<pg8::EpiResid, pg8::StaticOrder, true, true>(lds, g, S, E); }
    SEAM(10);
    if (IN(11)) ln_pass<2>(a, 0, 2, MLAT);
#undef IN
#undef SEAM
}

extern "C" void kernel_launch(void* const* d_in, const int* in_sizes, int n_in, void* d_out, int out_size, void* d_ws, size_t ws_size, hipStream_t stream) {
    static int grid = 0;
    if (grid == 0) {
        if (n_in != 21 || out_size != MLAT * D || ws_size < WS_END) { fprintf(stderr, "kernel_launch: unexpected shapes: n_in %d out %d ws %zu (need %zu)\n", n_in, out_size, ws_size, (size_t)WS_END); grid = -1; return; }
        int dev = 0, cus = 0, per_cu = 0;
        (void)hipGetDevice(&dev); (void)hipDeviceGetAttribute(&cus, hipDeviceAttributeMultiprocessorCount, dev);
        (void)hipFuncSetAttribute((const void*)mega, hipFuncAttributeMaxDynamicSharedMemorySize, LDS_BYTES);
        (void)hipOccupancyMaxActiveBlocksPerMultiprocessor(&per_cu, (const void*)mega, 512, LDS_BYTES);
        (void)hipGetLastError();
        grid = cus > 0 ? cus : 256; if (grid < 256) fprintf(stderr, "kernel_launch: this kernel needs >= 256 CUs (scan phase: one item per workgroup)\n");
        if (per_cu < 1) fprintf(stderr, "kernel_launch: occupancy query reports %d blocks per CU\n", per_cu);
    }
    if (grid < 0) return;
    Args a{};
    const float** p = (const float**)&a;
    for (int i = 0; i < 21; ++i) p[i] = (const float*)d_in[i];
    a.out = (float*)d_out; a.ws = (unsigned char*)d_ws; a.ph_lo = 0; a.ph_hi = 12;
    void* args[] = {&a};
    hipError_t e = hipLaunchCooperativeKernel((void*)mega, dim3(grid), dim3(512), args, LDS_BYTES, stream);
    if (e != hipSuccess) fprintf(stderr, "cooperative launch failed: %s (grid %d)\n", hipGetErrorString(e), grid);
}
```

```cpp
#include <hip/hip_runtime.h>
#include <hip/hip_cooperative_groups.h>
#include <cstdio>
#include <cstdint>
namespace cg = cooperative_groups;
namespace pg8 {
#define PG8_LAS __attribute__((address_space(3)))
typedef unsigned short bf16_t;
typedef short bf16x8 __attribute__((ext_vector_type(8)));
typedef float f32x4 __attribute__((ext_vector_type(4)));
typedef unsigned u32x4 __attribute__((ext_vector_type(4)));
constexpr int BM = 256, BK = 64, HALF = 128, HTB = HALF * BK * 2  , STAGE_BYTES = 8 * HTB, NXCD = 8, WGM = 8;

__host__ __device__ __forceinline__ int lds_byte(int r, int c) { const int st = (r >> 4) * 2 + (c >> 5), rr = r & 15, cc = c & 31, ob = rr * 64 + cc * 2; return st * 1024 + (ob ^ (((ob >> 9) & 1) << 5)); }
__host__ __device__ __forceinline__ void stage_rc(int b, int& R, int& C) { const int st = b / 1024, sb = b % 1024, swz = sb ^ (((sb >> 9) & 1) << 5); R = (st >> 1) * 16 + swz / 64; C = (st & 1) * 32 + (swz % 64) / 2; }
__host__ __device__ __forceinline__ int perm32(int rho) { const int n = rho >> 4, i = rho & 15; return 8 * (i >> 2) + 4 * n + (i & 3); }

struct Unit { int pm, pn; };
struct Gemm { const bf16_t* A; const bf16_t* Bt; int M, N, K; };

struct StaticOrder {
    int nM, nN, nwg, G, c;
    __host__ __device__ void init(int M, int N, int G_, int c_) { nM = M / BM; nN = N / BM; nwg = nM * nN; G = G_; c = c_; }
    __host__ __device__ bool next(int i, Unit& u) const {
        const long L = (long)i * G + c; if (L >= nwg) return false;
        int wgid = (int)L; { const int q = nwg / NXCD, r = nwg % NXCD, xcd = wgid % NXCD, off = wgid / NXCD; wgid = (xcd < r ? xcd * (q + 1) : r * (q + 1) + (xcd - r) * q) + off; }
        const int nig = WGM * nN, gid = wgid / nig, fm = gid * WGM, gsz = (nM - fm) < WGM ? (nM - fm) : WGM;
        u.pm = fm + ((wgid % nig) % gsz); u.pn = (wgid % nig) / gsz; return true;
    }
    __device__ __forceinline__ void a_ready(const Unit&) const {}
    __device__ __forceinline__ void done(const Unit&) const {}
};

__device__ __forceinline__ unsigned cvt_pk_bf16(float lo, float hi) { unsigned r; asm volatile("v_cvt_pk_bf16_f32 %0, %1, %2" : "=v"(r) : "v"(lo), "v"(hi)); return r; }
typedef float f32x2 __attribute__((ext_vector_type(2)));
__device__ __forceinline__ float silu_f(float g) { return g * __builtin_amdgcn_rcpf(1.0f + __builtin_amdgcn_exp2f(-1.44269504089f * g)); }
struct EpiBf16Plain {
    static constexpr bool PERM = true, AFTER_DRAIN = false;
    bf16_t* O; int ldc;
    __device__ __forceinline__ void operator()(const f32x4 (&acc)[2][2][4][2], const Unit& u, int wr, int wc, int fr, int fq) const {
        const int row0 = u.pm * BM + wr * 64 + fr; const int col0 = u.pn * BM + wc * 32 + 8 * fq;
#pragma unroll
        for (int ai = 0; ai < 2; ++ai)
#pragma unroll
            for (int m = 0; m < 4; ++m) { bf16_t* rowp = O + (size_t)(row0 + ai * HALF + m * 16) * ldc + col0;
#pragma unroll
                for (int bj = 0; bj < 2; ++bj) { const f32x4 v0 = acc[ai][bj][m][0], v1 = acc[ai][bj][m][1];
                    u32x4 w; w.x = cvt_pk_bf16(v0[0], v0[1]); w.y = cvt_pk_bf16(v0[2], v0[3]); w.z = cvt_pk_bf16(v1[0], v1[1]); w.w = cvt_pk_bf16(v1[2], v1[3]);
                    *(u32x4*)(rowp + bj * HALF) = w; } }
    }
};
struct EpiSwiGLU {
    static constexpr bool PERM = true, AFTER_DRAIN = false;
    bf16_t* O; int ldc;
    __device__ __forceinline__ void operator()(const f32x4 (&acc)[2][2][4][2], const Unit& u, int wr, int wc, int fr, int fq) const {
        const int row0 = u.pm * BM + wr * 64 + fr; const int col0 = u.pn * HALF + wc * 32 + 8 * fq;
#pragma unroll
        for (int ai = 0; ai < 2; ++ai)
#pragma unroll
            for (int m = 0; m < 4; ++m) { bf16_t* rowp = O + (size_t)(row0 + ai * HALF + m * 16) * ldc + col0;
                const f32x4 g0 = acc[ai][0][m][0], g1 = acc[ai][0][m][1], u0 = acc[ai][1][m][0], u1 = acc[ai][1][m][1];
                u32x4 w;
                w.x = cvt_pk_bf16(silu_f(g0[0]) * u0[0], silu_f(g0[1]) * u0[1]); w.y = cvt_pk_bf16(silu_f(g0[2]) * u0[2], silu_f(g0[3]) * u0[3]);
                w.z = cvt_pk_bf16(silu_f(g1[0]) * u1[0], silu_f(g1[1]) * u1[1]); w.w = cvt_pk_bf16(silu_f(g1[2]) * u1[2], silu_f(g1[3]) * u1[3]);
                *(u32x4*)rowp = w; }
    }
};
struct EpiResid {
    static constexpr bool PERM = false, AFTER_DRAIN = false;
    float* Xlat; float* Xctx; const float* mtab; int gate_idx; float w; float alpha;
    __device__ __forceinline__ void operator()(const f32x4 (&acc)[2][2][4][2], const Unit& u, int wr, int wc, int fr, int fq) const {
        const bool lat = u.pm < 256; const int b = lat ? (u.pm >> 3) : 32;
        const float* g = mtab + ((size_t)b * 9 + gate_idx) * 1024;
        float* X = lat ? Xlat + (size_t)u.pm * BM * 1024 : Xctx + (size_t)(u.pm - 256) * BM * 1024;
        const int col0 = u.pn * BM + wc * 32 + 4 * fq;
#pragma unroll
        for (int bj = 0; bj < 2; ++bj)
#pragma unroll
            for (int n = 0; n < 2; ++n) { const int col = col0 + bj * HALF + n * 16; f32x4 gv = *(const f32x4*)(g + col); gv = gv * w;
#pragma unroll
                for (int ai = 0; ai < 2; ++ai)
#pragma unroll
                    for (int m = 0; m < 4; ++m) { float* p = X + (size_t)(ai * HALF + wr * 64 + m * 16 + fr) * 1024 + col;
                        const f32x4 xv = *(const f32x4*)p; *(f32x4*)p = xv * alpha + gv * acc[ai][bj][m][n]; } }
    }
};
template <class Epi, class Sched, bool ALIGN_EPI = false, bool SP2 = false>
__device__ __forceinline__ void gemm_phase(PG8_LAS unsigned char* lds, const Gemm g, const Sched& S, const Epi& E) {
    const int tid = threadIdx.x, wid = __builtin_amdgcn_readfirstlane(tid >> 6), lane = tid & 63, wr = wid >> 2, wc = wid & 3, fr = lane & 15, fq = lane >> 4;
    const int K = g.K, nt = K / BK;
    unsigned voffA[2], voffB[2];
#pragma unroll
    for (int i = 0; i < 2; ++i) { int R, C; stage_rc(tid * 16 + i * 8192, R, C); const int Rb = Epi::PERM ? ((R & ~31) + perm32(R & 31)) : R;
        voffA[i] = (unsigned)(R * K + C) * 2u; voffB[i] = (unsigned)(Rb * K + C) * 2u; }
    const size_t kstep = (size_t)(BK * 2);
    const size_t hstep = (size_t)HALF * K * 2;
    const size_t tstep = 2 * hstep;
    const unsigned ldsw = (unsigned)wid * 1024u;
    const int aoff = lds_byte(wr * 64 + fr, fq * 8), boff = lds_byte(wc * 32 + fr, fq * 8);
#define PG8_SA(b, h) (((b) * 2 + (h)) * HTB)
#define PG8_SB(b, h) ((4 + (b) * 2 + (h)) * HTB)
#define PG8_STAGE(bufoff, gbase, voff) do { _Pragma("unroll") for (int _i = 0; _i < 2; ++_i) \
        __builtin_amdgcn_global_load_lds((const unsigned*)((const char*)(gbase) + (voff)[_i]), (PG8_LAS unsigned*)(lds + (bufoff) + ldsw + _i * 8192), 16, 0, 0); } while (0)
#define PG8_LDA(dst, b, h) do { _Pragma("unroll") for (int m = 0; m < 4; ++m) _Pragma("unroll") for (int k = 0; k < 2; ++k) dst[m][k] = *(const PG8_LAS bf16x8*)(lds + PG8_SA(b, h) + aoff + m * 2048 + k * 1024); } while (0)
#define PG8_LDB(dst, b, h) do { _Pragma("unroll") for (int n = 0; n < 2; ++n) _Pragma("unroll") for (int k = 0; k < 2; ++k) dst[n][k] = *(const PG8_LAS bf16x8*)(lds + PG8_SB(b, h) + boff + n * 2048 + k * 1024); } while (0)
#define PG8_MMA(ai, bj, At, Bt) do { __builtin_amdgcn_s_setprio(1); _Pragma("unroll") for (int m = 0; m < 4; ++m) _Pragma("unroll") for (int n = 0; n < 2; ++n) _Pragma("unroll") for (int k = 0; k < 2; ++k) \
        acc[ai][bj][m][n] = __builtin_amdgcn_mfma_f32_16x16x32_bf16(Bt[n][k], At[m][k], acc[ai][bj][m][n], 0, 0, 0); __builtin_amdgcn_s_setprio(0); } while (0)
#define PG8_WAIT_V(n) asm volatile("s_waitcnt vmcnt(" #n ")" ::: "memory")
#define PG8_WAIT_L(n) asm volatile("s_waitcnt lgkmcnt(" #n ")" ::: "memory")
#define PG8_BAR __builtin_amdgcn_s_barrier()
#define PG8_SCHED __builtin_amdgcn_sched_barrier(0)
    Unit cur, nxt; int ui = 0;
    if (!S.next(0, cur)) return;
    f32x4 acc[2][2][4][2];
#pragma unroll
    for (int a = 0; a < 2; ++a)
#pragma unroll
        for (int b = 0; b < 2; ++b)
#pragma unroll
            for (int m = 0; m < 4; ++m)
#pragma unroll
                for (int n = 0; n < 2; ++n) acc[a][b][m][n] = (f32x4){0.f, 0.f, 0.f, 0.f};
    bf16x8 At[4][2], B0[2][2], B1[2][2];
    const char* cA = (const char*)g.A + (size_t)cur.pm * tstep; const char* cB = (const char*)g.Bt + (size_t)cur.pn * tstep;
    S.a_ready(cur);
    if constexpr (SP2) {
        PG8_STAGE(PG8_SB(0, 0), cB, voffB); PG8_STAGE(PG8_SB(0, 1), cB + hstep, voffB); PG8_STAGE(PG8_SA(0, 0), cA, voffA); PG8_STAGE(PG8_SA(0, 1), cA + hstep, voffA);
        if (wr == 1) PG8_BAR;
        PG8_WAIT_V(2); PG8_BAR;
        PG8_STAGE(PG8_SB(1, 0), cB + kstep, voffB); PG8_STAGE(PG8_SA(1, 0), cA + kstep, voffA); PG8_STAGE(PG8_SB(1, 1), cB + hstep + kstep, voffB);
        PG8_WAIT_V(6); PG8_BAR;
    } else {
        PG8_STAGE(PG8_SB(0, 0), cB, voffB); PG8_STAGE(PG8_SA(0, 0), cA, voffA); PG8_STAGE(PG8_SB(0, 1), cB + hstep, voffB); PG8_STAGE(PG8_SA(0, 1), cA + hstep, voffA);
        if (wr == 1) PG8_BAR;
        PG8_WAIT_V(4); PG8_BAR;
        PG8_STAGE(PG8_SB(1, 0), cB + kstep, voffB); PG8_STAGE(PG8_SA(1, 0), cA + kstep, voffA); PG8_STAGE(PG8_SB(1, 1), cB + hstep + kstep, voffB);
        PG8_WAIT_V(6); PG8_BAR;
    }
    for (;;) {
        const bool has_next = S.next(ui + 1, nxt);
        const char* nA = has_next ? (const char*)g.A + (size_t)nxt.pm * tstep : cA; const char* nB = has_next ? (const char*)g.Bt + (size_t)nxt.pn * tstep : cB;
        for (int t = 0; t < nt; t += 2) {
            const bool last = (t == nt - 2);
            const char* a1 = cA + (size_t)(t + 1) * kstep;
            const char* a2 = last ? nA : cA + (size_t)(t + 2) * kstep; const char* b2 = last ? nB : cB + (size_t)(t + 2) * kstep;
            const char* a3 = a2 + kstep; const char* b3 = b2 + kstep;
            if (last && has_next) S.a_ready(nxt);
            if constexpr (SP2) {
            PG8_LDB(B0, 0, 0); PG8_LDB(B1, 0, 1); PG8_SCHED; PG8_LDA(At, 0, 0); PG8_STAGE(PG8_SA(1, 1), a1 + hstep, voffA);
            PG8_WAIT_V(8); PG8_WAIT_L(0); PG8_BAR; PG8_MMA(0, 0, At, B0); PG8_MMA(0, 1, At, B1); PG8_BAR; PG8_SCHED;
            PG8_LDA(At, 0, 1); PG8_STAGE(PG8_SB(0, 0), b2, voffB); PG8_STAGE(PG8_SB(0, 1), b2 + hstep, voffB); PG8_STAGE(PG8_SA(0, 0), a2, voffA);
            PG8_WAIT_V(8); PG8_WAIT_L(0); PG8_BAR; PG8_MMA(1, 0, At, B0); PG8_MMA(1, 1, At, B1); PG8_BAR; PG8_SCHED;
            PG8_LDB(B0, 1, 0); PG8_LDB(B1, 1, 1); PG8_SCHED; PG8_LDA(At, 1, 0); PG8_STAGE(PG8_SA(0, 1), a2 + hstep, voffA);
            PG8_WAIT_V(8); PG8_WAIT_L(0); PG8_BAR; PG8_MMA(0, 0, At, B0); PG8_MMA(0, 1, At, B1); PG8_BAR; PG8_SCHED;
            PG8_LDA(At, 1, 1); PG8_STAGE(PG8_SB(1, 0), b3, voffB); PG8_STAGE(PG8_SB(1, 1), b3 + hstep, voffB); PG8_STAGE(PG8_SA(1, 0), a3, voffA);
            PG8_WAIT_V(8); PG8_WAIT_L(0); PG8_BAR; PG8_MMA(1, 0, At, B0); PG8_MMA(1, 1, At, B1); PG8_BAR; PG8_SCHED;
            } else {
            PG8_LDB(B0, 0, 0); PG8_SCHED; PG8_LDA(At, 0, 0); PG8_STAGE(PG8_SA(1, 1), a1 + hstep, voffA);
            PG8_WAIT_L(8); PG8_BAR; PG8_WAIT_L(0); PG8_MMA(0, 0, At, B0); PG8_BAR; PG8_SCHED;
            PG8_LDB(B1, 0, 1); PG8_STAGE(PG8_SB(0, 0), b2, voffB);
            PG8_BAR; PG8_WAIT_L(0); PG8_MMA(0, 1, At, B1); PG8_BAR;
            PG8_LDA(At, 0, 1); PG8_STAGE(PG8_SA(0, 0), a2, voffA);
            PG8_BAR; PG8_WAIT_L(0); PG8_MMA(1, 0, At, B0); PG8_BAR; PG8_SCHED;
            PG8_STAGE(PG8_SB(0, 1), b2 + hstep, voffB);
            PG8_WAIT_V(6); PG8_BAR; PG8_MMA(1, 1, At, B1); PG8_BAR;
            PG8_LDB(B0, 1, 0); PG8_SCHED; PG8_LDA(At, 1, 0); PG8_STAGE(PG8_SA(0, 1), a2 + hstep, voffA);
            PG8_WAIT_L(8); PG8_BAR; PG8_WAIT_L(0); PG8_MMA(0, 0, At, B0); PG8_BAR; PG8_SCHED;
            PG8_LDB(B1, 1, 1); PG8_STAGE(PG8_SB(1, 0), b3, voffB);
            PG8_BAR; PG8_WAIT_L(0); PG8_MMA(0, 1, At, B1); PG8_BAR;
            PG8_LDA(At, 1, 1); PG8_STAGE(PG8_SA(1, 0), a3, voffA);
            PG8_BAR; PG8_WAIT_L(0); PG8_MMA(1, 0, At, B0); PG8_BAR; PG8_SCHED;
            PG8_STAGE(PG8_SB(1, 1), b3 + hstep, voffB);
            PG8_WAIT_V(6); PG8_BAR; PG8_MMA(1, 1, At, B1); PG8_BAR;
            }
        }
        if constexpr (ALIGN_EPI) { if (wr == 0) PG8_BAR; }
        if constexpr (!Epi::AFTER_DRAIN) { E(acc, cur, wr, wc, fr, fq); S.done(cur); }
        if (!has_next) break;
#pragma unroll
        for (int a = 0; a < 2; ++a)
#pragma unroll
            for (int b = 0; b < 2; ++b)
#pragma unroll
                for (int m = 0; m < 4; ++m)
#pragma unroll
                    for (int n = 0; n < 2; ++n) acc[a][b][m][n] = (f32x4){0.f, 0.f, 0.f, 0.f};
        cur = nxt; cA = nA; cB = nB; ++ui;
        if constexpr (ALIGN_EPI) { if (wr == 1) PG8_BAR; }
    }
    PG8_WAIT_V(0);
    if constexpr (!ALIGN_EPI) { if (wr == 0) PG8_BAR; }
    PG8_BAR;
    if constexpr (Epi::AFTER_DRAIN) { E.fused(acc, cur, wr, wc, fr, fq, lds, wid, lane); S.done(cur); }
#undef PG8_SA
#undef PG8_SB
#undef PG8_STAGE
#undef PG8_LDA
#undef PG8_LDB
#undef PG8_MMA
#undef PG8_WAIT_V
#undef PG8_WAIT_L
#undef PG8_BAR
#undef PG8_SCHED
}
}

#define LAS __attribute__((address_space(3)))
typedef unsigned short bf16;
typedef float f32x4 __attribute__((ext_vector_type(4)));
typedef float f32x16 __attribute__((ext_vector_type(16)));
typedef short bf16x8 __attribute__((ext_vector_type(8)));
typedef short s16x4 __attribute__((ext_vector_type(4)));
typedef unsigned u32x4 __attribute__((ext_vector_type(4)));
typedef unsigned u32x2 __attribute__((ext_vector_type(2)));

constexpr int D = 1024, NB = 32, T = 2048, TC = 256, DFF = 2816;
constexpr int MLAT = NB * T, MCTX = NB * TC, MALL = MLAT + MCTX;
constexpr int FW = 4352;
constexpr int GQ = 0, GK = 256, GV = 512, GG = 1024, HQ = 1536, HFF = 2048, HFB = 2560, HI = 3072, HG = 3584, LRF = 4096, LRB = 4112;
constexpr float LN_EPS = 1e-5f, NORM_EPS = 1e-6f;
constexpr float DN_ALPHA = 1.189207115002721f;
constexpr size_t MiB = 1u << 20;
constexpr size_t WS_M = 0, WS_TAB = 2 * MiB, WS_W1IN = 3 * MiB, WS_W1OUT = 14 * MiB, WS_WMIX = 20 * MiB, WS_WMO = 29 * MiB, WS_W2IN = 31 * MiB, WS_W2OUT = 42 * MiB,
                 WS_XC = 48 * MiB, WS_H = 80 * MiB, WS_OB = 224 * MiB, WS_FEAT = 352 * MiB, WS_END = 964 * MiB;
constexpr int LDS_BYTES = 147456;

struct Args {
    const float *x, *c, *ctx, *c_ctx, *w_ada, *b_ada, *ln_gain, *ln_bias, *ffn1_w_in, *ffn1_w_out, *w_mix_in, *a2_f, *a2_b, *abias_f, *abias_b, *lb_logits,
                *gla_gain, *hgrn_gain, *w_mix_out, *ffn2_w_in, *ffn2_w_out;
    float* out; unsigned char* ws; int ph_lo, ph_hi;
};

__device__ __forceinline__ unsigned f2bf(float f) { unsigned u = __builtin_bit_cast(unsigned, f); return (u + 0x7fffu + ((u >> 16) & 1u)) >> 16; }
__device__ __forceinline__ unsigned pk2(float lo, float hi) { return f2bf(lo) | (f2bf(hi) << 16); }
__device__ __forceinline__ float bf2f(unsigned short v) { return __builtin_bit_cast(float, (unsigned)v << 16); }
__device__ __forceinline__ float wave_sum(float v) {
#pragma unroll
    for (int o = 1; o < 64; o <<= 1) v += __shfl_xor(v, o);
    return v;
}
#define LDS_WAIT() asm volatile("s_waitcnt lgkmcnt(0)" ::: "memory")

__device__ __forceinline__ int remap_row(int kind, int n) {
    if (kind == 1) { const int half = n >= DFF ? 1 : 0, j = n - half * DFF; return 256 * (j >> 7) + 128 * half + (j & 127); }
    if (kind == 2) { return n < 1536 ? n : (n < 1568 ? 4096 + (n - 1536) : n - 32); }
    return n;
}
__device__ __forceinline__ void p0_transpose_item(const float* W, int K, int N, bf16* WT, int kind, LAS float* scr, int item, int lane) {
    const int nblk = N / 32, kb = item / nblk, nb = item % nblk, k0 = 64 * kb, n0 = 32 * nb;
    const int r0 = remap_row(kind, n0);
#pragma unroll 8
    for (int i = 0; i < 32; ++i) { const int kk = 2 * i + (lane >> 5); scr[kk * 33 + (lane & 31)] = W[(size_t)(k0 + kk) * N + n0 + (lane & 31)]; }
    LDS_WAIT(); asm volatile("" ::: "memory");
    const int c = lane & 7;
#pragma unroll
    for (int j = 0; j < 4; ++j) { const int n = (lane >> 3) + 8 * j; const LAS float* s = scr + (8 * c) * 33 + n;
        u32x4 o; o.x = pk2(s[0 * 33], s[1 * 33]); o.y = pk2(s[2 * 33], s[3 * 33]); o.z = pk2(s[4 * 33], s[5 * 33]); o.w = pk2(s[6 * 33], s[7 * 33]);
        *(u32x4*)(WT + (size_t)(r0 + n) * K + k0 + 8 * c) = o; }
    LDS_WAIT(); asm volatile("" ::: "memory");
}
__device__ __forceinline__ void p0_prologue(const Args& a, LAS unsigned char* lds) {
    const int tid = threadIdx.x, lane = tid & 63, wave = tid >> 6;
    const int G = gridDim.x, gw = blockIdx.x * 8 + wave, NGW = G * 8;
    unsigned char* ws = a.ws;
    {
        LAS float* scr = (LAS float*)(lds + wave * 16384);
        constexpr int I_IN = (D / 64) * (2 * DFF / 32), I_OUT = (DFF / 64) * (D / 32), I_MIX = (D / 64) * (4128 / 32), I_MO = (D / 64) * (D / 32);
        constexpr int NITEMS = 2 * I_IN + 2 * I_OUT + I_MIX + I_MO;
        for (int it = gw; it < NITEMS; it += NGW) {
            int r = it;
            if (r < I_IN) { p0_transpose_item(a.ffn1_w_in, D, 2 * DFF, (bf16*)(ws + WS_W1IN), 1, scr, r, lane); continue; } r -= I_IN;
            if (r < I_IN) { p0_transpose_item(a.ffn2_w_in, D, 2 * DFF, (bf16*)(ws + WS_W2IN), 1, scr, r, lane); continue; } r -= I_IN;
            if (r < I_OUT) { p0_transpose_item(a.ffn1_w_out, DFF, D, (bf16*)(ws + WS_W1OUT), 0, scr, r, lane); continue; } r -= I_OUT;
            if (r < I_OUT) { p0_transpose_item(a.ffn2_w_out, DFF, D, (bf16*)(ws + WS_W2OUT), 0, scr, r, lane); continue; } r -= I_OUT;
            if (r < I_MIX) { p0_transpose_item(a.w_mix_in, D, 4128, (bf16*)(ws + WS_WMIX), 2, scr, r, lane); continue; } r -= I_MIX;
            p0_transpose_item(a.w_mix_out, D, D, (bf16*)(ws + WS_WMO), 0, scr, r, lane);
        }
        u32x4* z = (u32x4*)((bf16*)(ws + WS_WMIX) + (size_t)4128 * D);
        for (int i = blockIdx.x * 512 + tid; i < 224 * D / 8; i += G * 512) z[i] = (u32x4){0u, 0u, 0u, 0u};
        float* tab = (float*)(ws + WS_TAB);
        for (int i = blockIdx.x * 512 + tid; i < 64 * 256; i += G * 512) { const int p = i >> 8, q = i & 255;
            const float omega = 1.0f / powf(10000.0f, (float)q * (1.0f / 256.0f)); const float ang = (float)p * omega;
            tab[p * 512 + q] = sinf(ang); tab[p * 512 + 256 + q] = cosf(ang); }
    }
    __syncthreads();
    for (int item = blockIdx.x; item < 9216 / 64; item += G) {
        LAS float* sc = (LAS float*)lds;
        for (int i = tid; i < 33 * 1024; i += 512) { const float v = i < 32 * 1024 ? a.c[i] : a.c_ctx[i - 32 * 1024]; sc[i] = v / (1.0f + __expf(-v)); }
        __syncthreads();
        float acc[33];
#pragma unroll
        for (int b = 0; b < 33; ++b) acc[b] = 0.f;
        const int n = item * 64 + lane;
        for (int k = wave * 128; k < wave * 128 + 128; ++k) { const float wv = a.w_ada[(size_t)k * 9216 + n];
#pragma unroll
            for (int b = 0; b < 33; ++b) acc[b] += sc[b * 1024 + k] * wv; }
        __syncthreads();
        LAS float* red = (LAS float*)lds;
#pragma unroll
        for (int b = 0; b < 33; ++b) red[(wave * 33 + b) * 64 + lane] = acc[b];
        __syncthreads();
        float* mt = (float*)(ws + WS_M);
        for (int i = tid; i < 33 * 64; i += 512) { const int b = i >> 6, l = i & 63; float s = 0.f;
#pragma unroll
            for (int w = 0; w < 8; ++w) s += red[(w * 33 + b) * 64 + l];
            mt[(size_t)b * 9216 + item * 64 + l] = s + a.b_ada[item * 64 + l]; }
        __syncthreads();
    }
}

template <int MODE>
__device__ __forceinline__ void ln_pass(const Args& a, int sub, int li, int nrows) {
    const int tid = threadIdx.x, lane = tid & 63, wave = tid >> 6;
    const int gw = blockIdx.x * 8 + wave, NGW = gridDim.x * 8;
    const float* mt = (const float*)(a.ws + WS_M);
    const float* tab = (const float*)(a.ws + WS_TAB);
    float* xc = (float*)(a.ws + WS_XC);
    bf16* H = (bf16*)(a.ws + WS_H);
    for (int r = gw; r < nrows; r += NGW) {
        const bool lat = r < MLAT; const int b = lat ? (r >> 11) : 32;
        float* Xrow = lat ? a.out + (size_t)r * D : xc + (size_t)(r - MLAT) * D;
        f32x4 v[4];
        if (MODE == 0) {
            const float* src = lat ? a.x + (size_t)r * D : a.ctx + (size_t)(r - MLAT) * D;
#pragma unroll
            for (int j = 0; j < 4; ++j) v[j] = *((const f32x4*)src + lane + 64 * j);
            if (lat) { const int t = r & 2047; const float* tr = tab + (t >> 6) * 512; const float* tcl = tab + (t & 63) * 512;
                v[0] += *((const f32x4*)tr + lane); v[1] += *((const f32x4*)tr + lane + 64); v[2] += *((const f32x4*)tcl + lane); v[3] += *((const f32x4*)tcl + lane + 64); }
#pragma unroll
            for (int j = 0; j < 4; ++j) *((f32x4*)Xrow + lane + 64 * j) = v[j];
        } else {
            float s = 0.f;
#pragma unroll
            for (int j = 0; j < 4; ++j) { v[j] = *((const f32x4*)Xrow + lane + 64 * j); s += (v[j].x + v[j].y) + (v[j].z + v[j].w); }
            const float mean = wave_sum(s) * (1.f / D); float s2 = 0.f;
#pragma unroll
            for (int j = 0; j < 4; ++j) { v[j] = v[j] - mean; s2 += (v[j].x * v[j].x + v[j].y * v[j].y) + (v[j].z * v[j].z + v[j].w * v[j].w); }
            const float rstd = 1.f / sqrtf(wave_sum(s2) * (1.f / D) + LN_EPS);
            const float* gn = a.ln_gain + li * D; const float* bs = a.ln_bias + li * D;
#pragma unroll
            for (int j = 0; j < 4; ++j) { const f32x4 g4 = *((const f32x4*)gn + lane + 64 * j), b4 = *((const f32x4*)bs + lane + 64 * j); v[j] = v[j] * rstd * g4 + b4; *((f32x4*)Xrow + lane + 64 * j) = v[j]; }
        }
        if (MODE != 2) {
            float s = 0.f;
#pragma unroll
            for (int j = 0; j < 4; ++j) s += (v[j].x + v[j].y) + (v[j].z + v[j].w);
            const float mean = wave_sum(s) * (1.f / D); float s2 = 0.f;
#pragma unroll
            for (int j = 0; j < 4; ++j) { v[j] = v[j] - mean; s2 += (v[j].x * v[j].x + v[j].y * v[j].y) + (v[j].z * v[j].z + v[j].w * v[j].w); }
            const float rstd = 1.f / sqrtf(wave_sum(s2) * (1.f / D) + LN_EPS);
            const float* m0 = mt + ((size_t)b * 9 + 3 * sub) * D; const float* m1 = m0 + D;
            u32x2* o8 = (u32x2*)(H + (size_t)r * D) + lane;
#pragma unroll
            for (int j = 0; j < 4; ++j) { const f32x4 s4 = *((const f32x4*)m0 + lane + 64 * j), t4 = *((const f32x4*)m1 + lane + 64 * j);
                const f32x4 h = v[j] * rstd * (s4 + 1.0f) + t4; u32x2 w; w.x = pk2(h.x, h.y); w.y = pk2(h.z, h.w); o8[64 * j] = w; }
        }
    }
}
__device__ __forceinline__ float silu_q(float g) { return g * __builtin_amdgcn_rcpf(1.0f + __expf(-g)); }

#define MFMA32(a_, b_, c_) __builtin_amdgcn_mfma_f32_32x32x16_bf16((a_), (b_), (c_), 0, 0, 0)
typedef float f32x2_t __attribute__((ext_vector_type(2)));
typedef __bf16 bf16x2_t __attribute__((ext_vector_type(2)));
__device__ __forceinline__ unsigned cvtpk(float lo, float hi) { f32x2_t v = {lo, hi}; bf16x2_t b = __builtin_convertvector(v, bf16x2_t); return __builtin_bit_cast(unsigned, b); }
__device__ __forceinline__ bf16x8 pack8(const f32x16& x, int s) {
    u32x4 p; p.x = cvtpk(x[8 * s], x[8 * s + 1]); p.y = cvtpk(x[8 * s + 2], x[8 * s + 3]); p.z = cvtpk(x[8 * s + 4], x[8 * s + 5]); p.w = cvtpk(x[8 * s + 6], x[8 * s + 7]);
    return __builtin_bit_cast(bf16x8, p);
}
__device__ __forceinline__ int scan_base(int s, int dir, int b) {
    if (s < 8) return MLAT + b * TC + 32 * (dir ? 7 - s : s);
    return b * T + 32 * (dir ? 63 - (s - 8) : s - 8);
}
template <int DK>
__device__ __forceinline__ void scan_item(const Args& a, LAS unsigned char* lds, const int b, const int head) {
    constexpr bool HGR = (DK == 128);
    constexpr int TPT = DK / 8, NG = 32 / TPT, QS = DK + 8, TS = 40;
    constexpr int OFF_QD = 0, OFF_KI = OFF_QD + 32 * QS * 2, OFF_KT = OFF_KI + 32 * QS * 2, OFF_VT = OFF_KT + DK * TS * 2, OFF_DEC = OFF_VT + 128 * TS * 2,
                  OFF_CS = OFF_DEC + DK * 4, OFF_SSQ = OFF_CS + NG * DK * 4, DIRB = 40960;
    static_assert(OFF_SSQ + 512 <= DIRB, "scan LDS map");
    const int tid = threadIdx.x, lane = tid & 63, wave = tid >> 6, dir = wave >> 2, dvq = wave & 3, gt = tid & 255;
    const int l31 = lane & 31, h = lane >> 5;
    LAS unsigned char* L = lds + dir * DIRB;
    LAS bf16* QD = (LAS bf16*)(L + OFF_QD); LAS bf16* KI = (LAS bf16*)(L + OFF_KI); LAS bf16* KT = (LAS bf16*)(L + OFF_KT); LAS bf16* VT = (LAS bf16*)(L + OFF_VT);
    LAS float* DEC = (LAS float*)(L + OFF_DEC); LAS float* CS = (LAS float*)(L + OFF_CS); LAS float* SSQ = (LAS float*)(L + OFF_SSQ);
    const bf16* F = (const bf16*)(a.ws + WS_FEAT);
    bf16* OB = (bf16*)(a.ws + WS_OB); bf16* MG = (bf16*)(a.ws + WS_H);
    const int c = gt % DK, tg = gt / DK;
    const int vn = gt & 127, vth = gt >> 7;
    float lbv = 0.f, abias = 0.f; float a2c[16];
#pragma unroll
    for (int r = 0; r < 16; ++r) a2c[r] = 0.f;
    if (HGR) { const float* lg = a.lb_logits + dir * 1024 + head * 128 + c; lbv = 1.0f / (1.0f + __expf(lg[512] - lg[0])); }
    else { const float* a2 = dir ? a.a2_b : a.a2_f;
#pragma unroll
        for (int r = 0; r < 16; ++r) a2c[r] = a2[r * 256 + head * 64 + c];
        abias = (dir ? a.abias_b : a.abias_f)[head * 64 + c]; }
    const int qcol = HGR ? HQ + head * 128 + c : GQ + head * 64 + c;
    const int kcol = HGR ? (dir ? HFB : HFF) + head * 128 + c : GK + head * 64 + c;
    const int vcol = (HGR ? HI : GV) + head * 128 + vn;
    const int lrcol = dir ? LRB : LRF;
    const int gcol = (HGR ? HG : GG) + head * 128;
    const int mcol = (HGR ? 512 : 0) + head * 128;
    const float* gain = HGR ? a.hgrn_gain : a.gla_gain;
    const float qscale = HGR ? 0.08838834764831845f : 0.125f;

    f32x16 S[DK / 32];
#pragma unroll
    for (int t = 0; t < DK / 32; ++t)
#pragma unroll
        for (int r = 0; r < 16; ++r) S[t][r] = 0.f;

    unsigned short rq[TPT], rk[TPT], rv[16];
#define SCAN_LOAD(s_) do { const int base_ = scan_base((s_), dir, b); \
        _Pragma("unroll") for (int i = 0; i < TPT; ++i) { const int ti = tg * TPT + i; const size_t row = (size_t)(base_ + (dir ? 31 - ti : ti)); \
            rq[i] = F[row * FW + qcol]; rk[i] = F[row * FW + kcol]; } \
        _Pragma("unroll") for (int i = 0; i < 16; ++i) { const int ti = 16 * vth + i; const size_t row = (size_t)(base_ + (dir ? 31 - ti : ti)); rv[i] = F[row * FW + vcol]; } } while (0)
    SCAN_LOAD(0);
    for (int s = 0; s < 72; ++s) {
        const bool is_out = s >= 8, second = s >= 40;
        const int base = scan_base(s, dir, b);
        float bl[TPT], qv[TPT], kv[TPT]; float run = 0.f;
#pragma unroll
        for (int i = 0; i < TPT; ++i) {
            float q = bf2f(rq[i]), g, k;
            if (HGR) { const float zf = bf2f(rk[i]); const float sg = __builtin_amdgcn_rcpf(1.0f + __expf(-zf)); const float f = lbv + (1.0f - lbv) * sg; g = __logf(f); k = 1.0f - f; q = silu_q(q) * qscale; }
            else { float z = abias; const int ti = tg * TPT + i; const size_t row = (size_t)(base + (dir ? 31 - ti : ti));
                u32x4 rl[2]; rl[0] = *(const u32x4*)(F + row * FW + lrcol); rl[1] = *(const u32x4*)(F + row * FW + lrcol + 8);
#pragma unroll
                for (int w = 0; w < 4; ++w) { const unsigned u0 = rl[w >> 1][(w & 1) * 2], u1 = rl[w >> 1][(w & 1) * 2 + 1];
                    z += __builtin_bit_cast(float, u0 << 16) * a2c[4 * w] + __builtin_bit_cast(float, u0 & 0xffff0000u) * a2c[4 * w + 1]
                       + __builtin_bit_cast(float, u1 << 16) * a2c[4 * w + 2] + __builtin_bit_cast(float, u1 & 0xffff0000u) * a2c[4 * w + 3]; }
                g = (fminf(z, 0.f) - __logf(1.0f + __expf(-fabsf(z)))) * 0.0625f; k = bf2f(rk[i]); q = q * qscale; }
            run += g; bl[i] = run; qv[i] = q; kv[i] = k;
        }
        CS[tg * DK + c] = run;
        { u32x4 w0, w1;
          w0.x = rv[0] | ((unsigned)rv[1] << 16); w0.y = rv[2] | ((unsigned)rv[3] << 16); w0.z = rv[4] | ((unsigned)rv[5] << 16); w0.w = rv[6] | ((unsigned)rv[7] << 16);
          w1.x = rv[8] | ((unsigned)rv[9] << 16); w1.y = rv[10] | ((unsigned)rv[11] << 16); w1.z = rv[12] | ((unsigned)rv[13] << 16); w1.w = rv[14] | ((unsigned)rv[15] << 16);
          *(LAS u32x4*)(VT + vn * TS + 16 * vth) = w0; *(LAS u32x4*)(VT + vn * TS + 16 * vth + 8) = w1; }
        __syncthreads();
        float prefix = 0.f, btot = 0.f;
#pragma unroll
        for (int t = 0; t < NG; ++t) { const float v = CS[t * DK + c]; btot += v; if (t < tg) prefix += v; }
        const float dec = __expf(btot);
        unsigned ktp[TPT / 2];
#pragma unroll
        for (int i = 0; i < TPT; i += 2) {
            const float e0 = __expf(prefix + bl[i]), e1 = __expf(prefix + bl[i + 1]);
            const float ki0 = kv[i] * __builtin_amdgcn_rcpf(e0), ki1 = kv[i + 1] * __builtin_amdgcn_rcpf(e1);
            if (is_out) { const int ti = tg * TPT + i;
                QD[ti * QS + c] = (bf16)f2bf(qv[i] * e0); QD[(ti + 1) * QS + c] = (bf16)f2bf(qv[i + 1] * e1);
                KI[ti * QS + c] = (bf16)f2bf(ki0); KI[(ti + 1) * QS + c] = (bf16)f2bf(ki1); }
            ktp[i >> 1] = cvtpk(ki0 * dec, ki1 * dec);
        }
#pragma unroll
        for (int i = 0; i < TPT / 8; ++i) { u32x4 w; w.x = ktp[4 * i]; w.y = ktp[4 * i + 1]; w.z = ktp[4 * i + 2]; w.w = ktp[4 * i + 3]; *(LAS u32x4*)(KT + c * TS + tg * TPT + 8 * i) = w; }
        if (tg == 0) DEC[c] = dec;
        if (s + 1 < 72) SCAN_LOAD(s + 1);
        __syncthreads();
        f32x16 OT;
#pragma unroll
        for (int r = 0; r < 16; ++r) OT[r] = 0.f;
        if (is_out) {
            f32x16 accT;
#pragma unroll
            for (int r = 0; r < 16; ++r) accT[r] = 0.f;
#pragma unroll
            for (int s2 = 0; s2 < DK / 16; ++s2) {
                const bf16x8 ka = *(const LAS bf16x8*)(KI + l31 * QS + 16 * s2 + 8 * h);
                const bf16x8 qb = *(const LAS bf16x8*)(QD + l31 * QS + 16 * s2 + 8 * h);
                accT = MFMA32(ka, qb, accT);
            }
#pragma unroll
            for (int r = 0; r < 16; ++r) { const int j = (r & 3) + 8 * (r >> 2) + 4 * h; if (j > l31) accT[r] = 0.f; }
#pragma unroll
            for (int u = 0; u < 2; ++u) {
                const bf16x8 ab = pack8(accT, u);
                const s16x4 lo = *(const LAS s16x4*)(VT + (32 * dvq + l31) * TS + 16 * u + 4 * h);
                const s16x4 hi = *(const LAS s16x4*)(VT + (32 * dvq + l31) * TS + 16 * u + 8 + 4 * h);
                const bf16x8 va = __builtin_shufflevector(lo, hi, 0, 1, 2, 3, 4, 5, 6, 7);
                OT = MFMA32(va, ab, OT);
            }
#pragma unroll
            for (int t = 0; t < DK / 32; ++t)
#pragma unroll
                for (int u = 0; u < 2; ++u) {
                    const bf16x8 sa = pack8(S[t], u);
                    const s16x4 lo = *(const LAS s16x4*)(QD + l31 * QS + 32 * t + 16 * u + 4 * h);
                    const s16x4 hi = *(const LAS s16x4*)(QD + l31 * QS + 32 * t + 16 * u + 8 + 4 * h);
                    const bf16x8 qb = __builtin_shufflevector(lo, hi, 0, 1, 2, 3, 4, 5, 6, 7);
                    OT = MFMA32(sa, qb, OT);
                }
        }
#pragma unroll
        for (int t = 0; t < DK / 32; ++t) {
#pragma unroll
            for (int g4 = 0; g4 < 4; ++g4) { const f32x4 d4 = *(const LAS f32x4*)(DEC + 32 * t + 8 * g4 + 4 * h);
                S[t][4 * g4] *= d4.x; S[t][4 * g4 + 1] *= d4.y; S[t][4 * g4 + 2] *= d4.z; S[t][4 * g4 + 3] *= d4.w; }
#pragma unroll
            for (int u = 0; u < 2; ++u) {
                const bf16x8 ka = *(const LAS bf16x8*)(KT + (32 * t + l31) * TS + 16 * u + 8 * h);
                const bf16x8 vb = *(const LAS bf16x8*)(VT + (32 * dvq + l31) * TS + 16 * u + 8 * h);
                S[t] = MFMA32(ka, vb, S[t]);
            }
        }
        if (is_out) {
            const size_t row = (size_t)(base + (dir ? 31 - l31 : l31));
            if (!second) {
#pragma unroll
                for (int g4 = 0; g4 < 4; ++g4) { u32x2 w; w.x = cvtpk(OT[4 * g4], OT[4 * g4 + 1]); w.y = cvtpk(OT[4 * g4 + 2], OT[4 * g4 + 3]);
                    *(u32x2*)(OB + row * D + mcol + 32 * dvq + 8 * g4 + 4 * h) = w; }
            } else {
                float ss = 0.f;
#pragma unroll
                for (int g4 = 0; g4 < 4; ++g4) { const u32x2 w = *(const u32x2*)(OB + row * D + mcol + 32 * dvq + 8 * g4 + 4 * h);
                    OT[4 * g4] += __builtin_bit_cast(float, w.x << 16); OT[4 * g4 + 1] += __builtin_bit_cast(float, w.x & 0xffff0000u);
                    OT[4 * g4 + 2] += __builtin_bit_cast(float, w.y << 16); OT[4 * g4 + 3] += __builtin_bit_cast(float, w.y & 0xffff0000u); }
#pragma unroll
                for (int r = 0; r < 16; ++r) ss += OT[r] * OT[r];
                ss += __shfl_xor(ss, 32);
                if (h == 0) SSQ[dvq * 32 + l31] = ss;
                __syncthreads();
                const float tot = (SSQ[l31] + SSQ[32 + l31]) + (SSQ[64 + l31] + SSQ[96 + l31]);
                const float rs = 1.0f / sqrtf(tot * (1.0f / 128.0f) + NORM_EPS);
#pragma unroll
                for (int g4 = 0; g4 < 4; ++g4) { const int vc = 32 * dvq + 8 * g4 + 4 * h;
                    const u32x2 gw = *(const u32x2*)(F + row * FW + gcol + vc); const f32x4 gn = *(const f32x4*)(gain + vc);
                    const float y0 = OT[4 * g4] * rs * gn.x * silu_q(__builtin_bit_cast(float, gw.x << 16)), y1 = OT[4 * g4 + 1] * rs * gn.y * silu_q(__builtin_bit_cast(float, gw.x & 0xffff0000u));
                    const float y2 = OT[4 * g4 + 2] * rs * gn.z * silu_q(__builtin_bit_cast(float, gw.y << 16)), y3 = OT[4 * g4 + 3] * rs * gn.w * silu_q(__builtin_bit_cast(float, gw.y & 0xffff0000u));
                    u32x2 w; w.x = cvtpk(y0, y1); w.y = cvtpk(y2, y3);
                    *(u32x2*)(MG + row * D + mcol + vc) = w; }
            }
        }
        __syncthreads();
    }
#undef SCAN_LOAD
}

__global__ void __launch_bounds__(512, 2) mega(Args a) {
    extern __shared__ __attribute__((aligned(16))) unsigned char lds_raw[];
    LAS unsigned char* lds = (LAS unsigned char*)lds_raw;
    cg::grid_group grid = cg::this_grid();
    unsigned char* ws = a.ws;
    const int lo = a.ph_lo, hi = a.ph_hi;
#define IN(k) (lo <= (k) && (k) < hi)
#define SEAM(k) do { if (IN(k) && IN((k) + 1)) grid.sync(); } while (0)
    float* xc = (float*)(ws + WS_XC); const float* mt = (const float*)(ws + WS_M);
    pg8::bf16_t* H = (pg8::bf16_t*)(ws + WS_H); pg8::bf16_t* HID = (pg8::bf16_t*)(ws + WS_FEAT); pg8::bf16_t* FEAT = (pg8::bf16_t*)(ws + WS_FEAT);
    const int G = gridDim.x, cu = blockIdx.x;

    if (IN(0)) p0_prologue(a, lds);
    SEAM(0);
    if (IN(1)) ln_pass<0>(a, 0, 0, MALL);
    SEAM(1);
    if (IN(2)) { pg8::Gemm g{H, (const pg8::bf16_t*)(ws + WS_W1IN), MALL, 2 * DFF, D}; pg8::StaticOrder S; S.init(MALL, 2 * DFF, G, cu);
        pg8::EpiSwiGLU E{HID, DFF}; pg8::gemm_phase<pg8::EpiSwiGLU, pg8::StaticOrder, true, true>(lds, g, S, E); }
    SEAM(2);
    if (IN(3)) { pg8::Gemm g{HID, (const pg8::bf16_t*)(ws + WS_W1OUT), MALL, D, DFF}; pg8::StaticOrder S; S.init(MALL, D, G, cu);
        pg8::EpiResid E{a.out, xc, mt, 2, 0.5f, DN_ALPHA}; pg8::gemm_phase<pg8::EpiResid, pg8::StaticOrder, true, true>(lds, g, S, E); }
    SEAM(3);
    if (IN(4)) ln_pass<1>(a, 1, 0, MALL);
    SEAM(4);
    if (IN(5)) { pg8::Gemm g{H, (const pg8::bf16_t*)(ws + WS_WMIX), MALL, FW, D}; pg8::StaticOrder S; S.init(MALL, FW, G, cu);
        pg8::EpiBf16Plain E{FEAT, FW}; pg8::gemm_phase<pg8::EpiBf16Plain, pg8::StaticOrder, true, true>(lds, g, S, E); }
    SEAM(5);
    if (IN(6)) {
        if (cu < 256) { const int item = cu; const int b = item >> 3, grp = (item >> 2) & 1, head = item & 3;
            if (grp) scan_item<128>(a, lds, b, head); else scan_item<64>(a, lds, b, head); }
    }
    SEAM(6);
    if (IN(7)) { pg8::Gemm g{H, (const pg8::bf16_t*)(ws + WS_WMO), MLAT, D, D}; pg8::StaticOrder S; S.init(MLAT, D, G, cu);
        pg8::EpiResid E{a.out, xc, mt, 5, 1.0f, DN_ALPHA}; pg8::gemm_phase<pg8::EpiResid, pg8::StaticOrder, true, true>(lds, g, S, E); }
    SEAM(7);
    if (IN(8)) ln_pass<1>(a, 2, 1, MLAT);
    SEAM(8);
    if (IN(9)) { pg8::Gemm g{H, (const pg8::bf16_t*)(ws + WS_W2IN), MLAT, 2 * DFF, D}; pg8::StaticOrder S; S.init(MLAT, 2 * DFF, G, cu);
        pg8::EpiSwiGLU E{HID, DFF}; pg8::gemm_phase<pg8::EpiSwiGLU, pg8::StaticOrder, true, true>(lds, g, S, E); }
    SEAM(9);
    if (IN(10)) { pg8::Gemm g{HID, (const pg8::bf16_t*)(ws + WS_W2OUT), MLAT, D, DFF}; pg8::StaticOrder S; S.init(MLAT, D, G, cu);
        pg8::EpiResid E{a.out, xc, mt, 8, 0.5f, DN_ALPHA}; pg8::gemm_phase<pg8::EpiResid, pg8::StaticOrder, true, true>(lds, g, S, E); }
    SEAM(10);
    if (IN(11)) ln_pass<2>(a, 0, 2, MLAT);
#undef IN
#undef SEAM
}

extern "C" void kernel_launch(void* const* d_in, const int* in_sizes, int n_in, void* d_out, int out_size, void* d_ws, size_t ws_size, hipStream_t stream) {
    static int grid = 0;
    if (grid == 0) {
        if (n_in != 21 || out_size != MLAT * D || ws_size < WS_END) { fprintf(stderr, "kernel_launch: unexpected shapes: n_in %d out %d ws %zu (need %zu)\n", n_in, out_size, ws_size, (size_t)WS_END); grid = -1; return; }
        int dev = 0, cus = 0, per_cu = 0;
        (void)hipGetDevice(&dev); (void)hipDeviceGetAttribute(&cus, hipDeviceAttributeMultiprocessorCount, dev);
        (void)hipFuncSetAttribute((const void*)mega, hipFuncAttributeMaxDynamicSharedMemorySize, LDS_BYTES);
        (void)hipOccupancyMaxActiveBlocksPerMultiprocessor(&per_cu, (const void*)mega, 512, LDS_BYTES);
        (void)hipGetLastError();
        grid = cus > 0 ? cus : 256; if (grid < 256) fprintf(stderr, "kernel_launch: this kernel needs >= 256 CUs (scan phase: one item per workgroup)\n");
        if (per_cu < 1) fprintf(stderr, "kernel_launch: occupancy query reports %d blocks per CU\n", per_cu);
    }
    if (grid < 0) return;
    Args a{};
    const float** p = (const float**)&a;
    for (int i = 0; i < 21; ++i) p[i] = (const float*)d_in[i];
    a.out = (float*)d_out; a.ws = (unsigned char*)d_ws; a.ph_lo = 0; a.ph_hi = 12;
    void* args[] = {&a};
    hipError_t e = hipLaunchCooperativeKernel((void*)mega, dim3(grid), dim3(512), args, LDS_BYTES, stream);
    if (e != hipSuccess) fprintf(stderr, "cooperative launch failed: %s (grid %d)\n", hipGetErrorString(e), grid);
}
```

```cpp
#include <hip/hip_runtime.h>
#include <hip/hip_cooperative_groups.h>
#include <cstdio>
#include <cstdint>
namespace cg = cooperative_groups;
namespace pg8 {
#define PG8_LAS __attribute__((address_space(3)))
typedef unsigned short bf16_t;
typedef short bf16x8 __attribute__((ext_vector_type(8)));
typedef float f32x4 __attribute__((ext_vector_type(4)));
typedef unsigned u32x4 __attribute__((ext_vector_type(4)));
constexpr int BM = 256, BK = 64, HALF = 128, HTB = HALF * BK * 2  , STAGE_BYTES = 8 * HTB, NXCD = 8, WGM = 8;

__host__ __device__ __forceinline__ int lds_byte(int r, int c) { const int st = (r >> 4) * 2 + (c >> 5), rr = r & 15, cc = c & 31, ob = rr * 64 + cc * 2; return st * 1024 + (ob ^ (((ob >> 9) & 1) << 5)); }
__host__ __device__ __forceinline__ void stage_rc(int b, int& R, int& C) { const int st = b / 1024, sb = b % 1024, swz = sb ^ (((sb >> 9) & 1) << 5); R = (st >> 1) * 16 + swz / 64; C = (st & 1) * 32 + (swz % 64) / 2; }
__host__ __device__ __forceinline__ int perm32(int rho) { const int n = rho >> 4, i = rho & 15; return 8 * (i >> 2) + 4 * n + (i & 3); }

struct Unit { int pm, pn; };
struct Gemm { const bf16_t* A; const bf16_t* Bt; int M, N, K; };

struct StaticOrder {
    int nM, nN, nwg, G, c;
    __host__ __device__ void init(int M, int N, int G_, int c_) { nM = M / BM; nN = N / BM; nwg = nM * nN; G = G_; c = c_; }
    __host__ __device__ bool next(int i, Unit& u) const {
        const long L = (long)i * G + c; if (L >= nwg) return false;
        int wgid = (int)L; { const int q = nwg / NXCD, r = nwg % NXCD, xcd = wgid % NXCD, off = wgid / NXCD; wgid = (xcd < r ? xcd * (q + 1) : r * (q + 1) + (xcd - r) * q) + off; }
        const int nig = WGM * nN, gid = wgid / nig, fm = gid * WGM, gsz = (nM - fm) < WGM ? (nM - fm) : WGM;
        u.pm = fm + ((wgid % nig) % gsz); u.pn = (wgid % nig) / gsz; return true;
    }
    __device__ __forceinline__ void a_ready(const Unit&) const {}
    __device__ __forceinline__ void done(const Unit&) const {}
};

__device__ __forceinline__ unsigned cvt_pk_bf16(float lo, float hi) { unsigned r; asm volatile("v_cvt_pk_bf16_f32 %0, %1, %2" : "=v"(r) : "v"(lo), "v"(hi)); return r; }
typedef float f32x2 __attribute__((ext_vector_type(2)));
__device__ __forceinline__ float silu_f(float g) { return g * __builtin_amdgcn_rcpf(1.0f + __builtin_amdgcn_exp2f(-1.44269504089f * g)); }
struct EpiBf16Plain {
    static constexpr bool PERM = true, AFTER_DRAIN = false;
    bf16_t* O; int ldc;
    __device__ __forceinline__ void operator()(const f32x4 (&acc)[2][2][4][2], const Unit& u, int wr, int wc, int fr, int fq) const {
        const int row0 = u.pm * BM + wr * 64 + fr; const int col0 = u.pn * BM + wc * 32 + 8 * fq;
#pragma unroll
        for (int ai = 0; ai < 2; ++ai)
#pragma unroll
            for (int m = 0; m < 4; ++m) { bf16_t* rowp = O + (size_t)(row0 + ai * HALF + m * 16) * ldc + col0;
#pragma unroll
                for (int bj = 0; bj < 2; ++bj) { const f32x4 v0 = acc[ai][bj][m][0], v1 = acc[ai][bj][m][1];
                    u32x4 w; w.x = cvt_pk_bf16(v0[0], v0[1]); w.y = cvt_pk_bf16(v0[2], v0[3]); w.z = cvt_pk_bf16(v1[0], v1[1]); w.w = cvt_pk_bf16(v1[2], v1[3]);
                    *(u32x4*)(rowp + bj * HALF) = w; } }
    }
};
struct EpiBf16Blk {
    static constexpr bool PERM = true, AFTER_DRAIN = false;
    bf16_t* O; int Mrows;
    __device__ __forceinline__ void operator()(const f32x4 (&acc)[2][2][4][2], const Unit& u, int wr, int wc, int fr, int fq) const {
        const int row0 = u.pm * BM + wr * 64 + fr; const int col0 = wc * 32 + 8 * fq;
#pragma unroll
        for (int ai = 0; ai < 2; ++ai)
#pragma unroll
            for (int m = 0; m < 4; ++m) {
#pragma unroll
                for (int bj = 0; bj < 2; ++bj) { const f32x4 v0 = acc[ai][bj][m][0], v1 = acc[ai][bj][m][1];
                    u32x4 w; w.x = cvt_pk_bf16(v0[0], v0[1]); w.y = cvt_pk_bf16(v0[2], v0[3]); w.z = cvt_pk_bf16(v1[0], v1[1]); w.w = cvt_pk_bf16(v1[2], v1[3]);
                    *(u32x4*)(O + ((size_t)(2 * u.pn + bj) * Mrows + (row0 + ai * HALF + m * 16)) * 128 + col0) = w; } }
    }
};
struct EpiFeat {
    static constexpr bool PERM = true, AFTER_DRAIN = false;
    bf16_t* O; int Mrows; const float* oml;
    __device__ __forceinline__ void operator()(const f32x4 (&acc)[2][2][4][2], const Unit& u, int wr, int wc, int fr, int fq) const {
        const int row0 = u.pm * BM + wr * 64 + fr; const int col0 = wc * 32 + 8 * fq; const int pn = u.pn;
        const int mode = pn == 0 ? 1 : ((pn == 6 || pn == 7) ? 2 : ((pn >= 8 && pn <= 11) ? 3 : ((pn == 4 || pn == 5 || pn == 14 || pn == 15) ? 4 : 0)));
        const float* omp = oml + (pn >= 10 ? 512 : 0) + (pn & 1) * 256 + col0;
#pragma unroll
        for (int ai = 0; ai < 2; ++ai)
#pragma unroll
            for (int m = 0; m < 4; ++m) {
#pragma unroll
                for (int bj = 0; bj < 2; ++bj) { f32x4 v0 = acc[ai][bj][m][0], v1 = acc[ai][bj][m][1];
                    if (mode == 1) { v0 = v0 * 0.125f; v1 = v1 * 0.125f; }
                    else if (mode == 2) {
#pragma unroll
                        for (int e = 0; e < 4; ++e) { v0[e] = silu_f(v0[e]) * 0.08838834764831845f; v1[e] = silu_f(v1[e]) * 0.08838834764831845f; } }
                    else if (mode == 4) {
#pragma unroll
                        for (int e = 0; e < 4; ++e) { v0[e] = silu_f(v0[e]); v1[e] = silu_f(v1[e]); } }
                    else if (mode == 3) { const f32x4 o0 = *(const f32x4*)(omp + bj * HALF), o1 = *(const f32x4*)(omp + bj * HALF + 4);
#pragma unroll
                        for (int e = 0; e < 4; ++e) { v0[e] = o0[e] * __builtin_amdgcn_rcpf(1.0f + __builtin_amdgcn_exp2f(1.44269504089f * v0[e]));
                                                      v1[e] = o1[e] * __builtin_amdgcn_rcpf(1.0f + __builtin_amdgcn_exp2f(1.44269504089f * v1[e])); } }
                    u32x4 w; w.x = cvt_pk_bf16(v0[0], v0[1]); w.y = cvt_pk_bf16(v0[2], v0[3]); w.z = cvt_pk_bf16(v1[0], v1[1]); w.w = cvt_pk_bf16(v1[2], v1[3]);
                    *(u32x4*)(O + ((size_t)(2 * pn + bj) * Mrows + (row0 + ai * HALF + m * 16)) * 128 + col0) = w; } }
    }
};
struct EpiSwiGLU {
    static constexpr bool PERM = true, AFTER_DRAIN = false;
    bf16_t* O; int ldc;
    __device__ __forceinline__ void operator()(const f32x4 (&acc)[2][2][4][2], const Unit& u, int wr, int wc, int fr, int fq) const {
        const int row0 = u.pm * BM + wr * 64 + fr; const int col0 = u.pn * HALF + wc * 32 + 8 * fq;
#pragma unroll
        for (int ai = 0; ai < 2; ++ai)
#pragma unroll
            for (int m = 0; m < 4; ++m) { bf16_t* rowp = O + (size_t)(row0 + ai * HALF + m * 16) * ldc + col0;
                const f32x4 g0 = acc[ai][0][m][0], g1 = acc[ai][0][m][1], u0 = acc[ai][1][m][0], u1 = acc[ai][1][m][1];
                u32x4 w;
                w.x = cvt_pk_bf16(silu_f(g0[0]) * u0[0], silu_f(g0[1]) * u0[1]); w.y = cvt_pk_bf16(silu_f(g0[2]) * u0[2], silu_f(g0[3]) * u0[3]);
                w.z = cvt_pk_bf16(silu_f(g1[0]) * u1[0], silu_f(g1[1]) * u1[1]); w.w = cvt_pk_bf16(silu_f(g1[2]) * u1[2], silu_f(g1[3]) * u1[3]);
                *(u32x4*)rowp = w; }
    }
};
struct EpiResid {
    static constexpr bool PERM = false, AFTER_DRAIN = false;
    float* Xlat; float* Xctx; const float* mtab; int gate_idx; float w; float alpha;
    __device__ __forceinline__ void operator()(const f32x4 (&acc)[2][2][4][2], const Unit& u, int wr, int wc, int fr, int fq) const {
        const bool lat = u.pm < 256; const int b = lat ? (u.pm >> 3) : 32;
        const float* g = mtab + ((size_t)b * 9 + gate_idx) * 1024;
        float* X = lat ? Xlat + (size_t)u.pm * BM * 1024 : Xctx + (size_t)(u.pm - 256) * BM * 1024;
        const int col0 = u.pn * BM + wc * 32 + 4 * fq;
#pragma unroll
        for (int bj = 0; bj < 2; ++bj)
#pragma unroll
            for (int n = 0; n < 2; ++n) { const int col = col0 + bj * HALF + n * 16; f32x4 gv = *(const f32x4*)(g + col); gv = gv * w;
#pragma unroll
                for (int ai = 0; ai < 2; ++ai)
#pragma unroll
                    for (int m = 0; m < 4; ++m) { float* p = X + (size_t)(ai * HALF + wr * 64 + m * 16 + fr) * 1024 + col;
                        const f32x4 xv = *(const f32x4*)p; *(f32x4*)p = xv * alpha + gv * acc[ai][bj][m][n]; } }
    }
};
template <class Epi, class Sched, bool ALIGN_EPI = false, bool SP2 = false>
__device__ __forceinline__ void gemm_phase(PG8_LAS unsigned char* lds, const Gemm g, const Sched& S, const Epi& E) {
    const int tid = threadIdx.x, wid = __builtin_amdgcn_readfirstlane(tid >> 6), lane = tid & 63, wr = wid >> 2, wc = wid & 3, fr = lane & 15, fq = lane >> 4;
    const int K = g.K, nt = K / BK;
    unsigned voffA[2], voffB[2];
#pragma unroll
    for (int i = 0; i < 2; ++i) { int R, C; stage_rc(tid * 16 + i * 8192, R, C); const int Rb = Epi::PERM ? ((R & ~31) + perm32(R & 31)) : R;
        voffA[i] = (unsigned)(R * K + C) * 2u; voffB[i] = (unsigned)(Rb * K + C) * 2u; }
    const size_t kstep = (size_t)(BK * 2);
    const size_t hstep = (size_t)HALF * K * 2;
    const size_t tstep = 2 * hstep;
    const unsigned ldsw = (unsigned)wid * 1024u;
    const int aoff = lds_byte(wr * 64 + fr, fq * 8), boff = lds_byte(wc * 32 + fr, fq * 8);
#define PG8_SA(b, h) (((b) * 2 + (h)) * HTB)
#define PG8_SB(b, h) ((4 + (b) * 2 + (h)) * HTB)
#define PG8_STAGE(bufoff, gbase, voff) do { _Pragma("unroll") for (int _i = 0; _i < 2; ++_i) \
        __builtin_amdgcn_global_load_lds((const unsigned*)((const char*)(gbase) + (voff)[_i]), (PG8_LAS unsigned*)(lds + (bufoff) + ldsw + _i * 8192), 16, 0, 0); } while (0)
#define PG8_LDA(dst, b, h) do { _Pragma("unroll") for (int m = 0; m < 4; ++m) _Pragma("unroll") for (int k = 0; k < 2; ++k) dst[m][k] = *(const PG8_LAS bf16x8*)(lds + PG8_SA(b, h) + aoff + m * 2048 + k * 1024); } while (0)
#define PG8_LDB(dst, b, h) do { _Pragma("unroll") for (int n = 0; n < 2; ++n) _Pragma("unroll") for (int k = 0; k < 2; ++k) dst[n][k] = *(const PG8_LAS bf16x8*)(lds + PG8_SB(b, h) + boff + n * 2048 + k * 1024); } while (0)
#define PG8_MMA(ai, bj, At, Bt) do { __builtin_amdgcn_s_setprio(1); _Pragma("unroll") for (int m = 0; m < 4; ++m) _Pragma("unroll") for (int n = 0; n < 2; ++n) _Pragma("unroll") for (int k = 0; k < 2; ++k) \
        acc[ai][bj][m][n] = __builtin_amdgcn_mfma_f32_16x16x32_bf16(Bt[n][k], At[m][k], acc[ai][bj][m][n], 0, 0, 0); __builtin_amdgcn_s_setprio(0); } while (0)
#define PG8_WAIT_V(n) asm volatile("s_waitcnt vmcnt(" #n ")" ::: "memory")
#define PG8_WAIT_L(n) asm volatile("s_waitcnt lgkmcnt(" #n ")" ::: "memory")
#define PG8_BAR __builtin_amdgcn_s_barrier()
#define PG8_SCHED __builtin_amdgcn_sched_barrier(0)
    Unit cur, nxt; int ui = 0;
    if (!S.next(0, cur)) return;
    f32x4 acc[2][2][4][2];
#pragma unroll
    for (int a = 0; a < 2; ++a)
#pragma unroll
        for (int b = 0; b < 2; ++b)
#pragma unroll
            for (int m = 0; m < 4; ++m)
#pragma unroll
                for (int n = 0; n < 2; ++n) acc[a][b][m][n] = (f32x4){0.f, 0.f, 0.f, 0.f};
    bf16x8 At[4][2], B0[2][2], B1[2][2];
    const char* cA = (const char*)g.A + (size_t)cur.pm * tstep; const char* cB = (const char*)g.Bt + (size_t)cur.pn * tstep;
    S.a_ready(cur);
    if constexpr (SP2) {
        PG8_STAGE(PG8_SB(0, 0), cB, voffB); PG8_STAGE(PG8_SB(0, 1), cB + hstep, voffB); PG8_STAGE(PG8_SA(0, 0), cA, voffA); PG8_STAGE(PG8_SA(0, 1), cA + hstep, voffA);
        if (wr == 1) PG8_BAR;
        PG8_WAIT_V(2); PG8_BAR;
        PG8_STAGE(PG8_SB(1, 0), cB + kstep, voffB); PG8_STAGE(PG8_SA(1, 0), cA + kstep, voffA); PG8_STAGE(PG8_SB(1, 1), cB + hstep + kstep, voffB);
        PG8_WAIT_V(6); PG8_BAR;
    } else {
        PG8_STAGE(PG8_SB(0, 0), cB, voffB); PG8_STAGE(PG8_SA(0, 0), cA, voffA); PG8_STAGE(PG8_SB(0, 1), cB + hstep, voffB); PG8_STAGE(PG8_SA(0, 1), cA + hstep, voffA);
        if (wr == 1) PG8_BAR;
        PG8_WAIT_V(4); PG8_BAR;
        PG8_STAGE(PG8_SB(1, 0), cB + kstep, voffB); PG8_STAGE(PG8_SA(1, 0), cA + kstep, voffA); PG8_STAGE(PG8_SB(1, 1), cB + hstep + kstep, voffB);
        PG8_WAIT_V(6); PG8_BAR;
    }
    for (;;) {
        const bool has_next = S.next(ui + 1, nxt);
        const char* nA = has_next ? (const char*)g.A + (size_t)nxt.pm * tstep : cA; const char* nB = has_next ? (const char*)g.Bt + (size_t)nxt.pn * tstep : cB;
        for (int t = 0; t < nt; t += 2) {
            const bool last = (t == nt - 2);
            const char* a1 = cA + (size_t)(t + 1) * kstep;
            const char* a2 = last ? nA : cA + (size_t)(t + 2) * kstep; const char* b2 = last ? nB : cB + (size_t)(t + 2) * kstep;
            const char* a3 = a2 + kstep; const char* b3 = b2 + kstep;
            if (last && has_next) S.a_ready(nxt);
            if constexpr (SP2) {
            PG8_LDB(B0, 0, 0); PG8_LDB(B1, 0, 1); PG8_SCHED; PG8_LDA(At, 0, 0); PG8_STAGE(PG8_SA(1, 1), a1 + hstep, voffA);
            PG8_WAIT_V(8); PG8_WAIT_L(0); PG8_BAR; PG8_MMA(0, 0, At, B0); PG8_MMA(0, 1, At, B1); PG8_BAR; PG8_SCHED;
            PG8_LDA(At, 0, 1); PG8_STAGE(PG8_SB(0, 0), b2, voffB); PG8_STAGE(PG8_SB(0, 1), b2 + hstep, voffB); PG8_STAGE(PG8_SA(0, 0), a2, voffA);
            PG8_WAIT_V(8); PG8_WAIT_L(0); PG8_BAR; PG8_MMA(1, 0, At, B0); PG8_MMA(1, 1, At, B1); PG8_BAR; PG8_SCHED;
            PG8_LDB(B0, 1, 0); PG8_LDB(B1, 1, 1); PG8_SCHED; PG8_LDA(At, 1, 0); PG8_STAGE(PG8_SA(0, 1), a2 + hstep, voffA);
            PG8_WAIT_V(8); PG8_WAIT_L(0); PG8_BAR; PG8_MMA(0, 0, At, B0); PG8_MMA(0, 1, At, B1); PG8_BAR; PG8_SCHED;
            PG8_LDA(At, 1, 1); PG8_STAGE(PG8_SB(1, 0), b3, voffB); PG8_STAGE(PG8_SB(1, 1), b3 + hstep, voffB); PG8_STAGE(PG8_SA(1, 0), a3, voffA);
            PG8_WAIT_V(8); PG8_WAIT_L(0); PG8_BAR; PG8_MMA(1, 0, At, B0); PG8_MMA(1, 1, At, B1); PG8_BAR; PG8_SCHED;
            } else {
            PG8_LDB(B0, 0, 0); PG8_SCHED; PG8_LDA(At, 0, 0); PG8_STAGE(PG8_SA(1, 1), a1 + hstep, voffA);
            PG8_WAIT_L(8); PG8_BAR; PG8_WAIT_L(0); PG8_MMA(0, 0, At, B0); PG8_BAR; PG8_SCHED;
            PG8_LDB(B1, 0, 1); PG8_STAGE(PG8_SB(0, 0), b2, voffB);
            PG8_BAR; PG8_WAIT_L(0); PG8_MMA(0, 1, At, B1); PG8_BAR;
            PG8_LDA(At, 0, 1); PG8_STAGE(PG8_SA(0, 0), a2, voffA);
            PG8_BAR; PG8_WAIT_L(0); PG8_MMA(1, 0, At, B0); PG8_BAR; PG8_SCHED;
            PG8_STAGE(PG8_SB(0, 1), b2 + hstep, voffB);
            PG8_WAIT_V(6); PG8_BAR; PG8_MMA(1, 1, At, B1); PG8_BAR;
            PG8_LDB(B0, 1, 0); PG8_SCHED; PG8_LDA(At, 1, 0); PG8_STAGE(PG8_SA(0, 1), a2 + hstep, voffA);
            PG8_WAIT_L(8); PG8_BAR; PG8_WAIT_L(0); PG8_MMA(0, 0, At, B0); PG8_BAR; PG8_SCHED;
            PG8_LDB(B1, 1, 1); PG8_STAGE(PG8_SB(1, 0), b3, voffB);
            PG8_BAR; PG8_WAIT_L(0); PG8_MMA(0, 1, At, B1); PG8_BAR;
            PG8_LDA(At, 1, 1); PG8_STAGE(PG8_SA(1, 0), a3, voffA);
            PG8_BAR; PG8_WAIT_L(0); PG8_MMA(1, 0, At, B0); PG8_BAR; PG8_SCHED;
            PG8_STAGE(PG8_SB(1, 1), b3 + hstep, voffB);
            PG8_WAIT_V(6); PG8_BAR; PG8_MMA(1, 1, At, B1); PG8_BAR;
            }
        }
        if constexpr (ALIGN_EPI) { if (wr == 0) PG8_BAR; }
        if constexpr (!Epi::AFTER_DRAIN) { E(acc, cur, wr, wc, fr, fq); S.done(cur); }
        if (!has_next) break;
#pragma unroll
        for (int a = 0; a < 2; ++a)
#pragma unroll
            for (int b = 0; b < 2; ++b)
#pragma unroll
                for (int m = 0; m < 4; ++m)
#pragma unroll
                    for (int n = 0; n < 2; ++n) acc[a][b][m][n] = (f32x4){0.f, 0.f, 0.f, 0.f};
        cur = nxt; cA = nA; cB = nB; ++ui;
        if constexpr (ALIGN_EPI) { if (wr == 1) PG8_BAR; }
    }
    PG8_WAIT_V(0);
    if constexpr (!ALIGN_EPI) { if (wr == 0) PG8_BAR; }
    PG8_BAR;
    if constexpr (Epi::AFTER_DRAIN) { E.fused(acc, cur, wr, wc, fr, fq, lds, wid, lane); S.done(cur); }
#undef PG8_SA
#undef PG8_SB
#undef PG8_STAGE
#undef PG8_LDA
#undef PG8_LDB
#undef PG8_MMA
#undef PG8_WAIT_V
#undef PG8_WAIT_L
#undef PG8_BAR
#undef PG8_SCHED
}
}

#define LAS __attribute__((address_space(3)))
typedef unsigned short bf16;
typedef float f32x4 __attribute__((ext_vector_type(4)));
typedef float f32x16 __attribute__((ext_vector_type(16)));
typedef short bf16x8 __attribute__((ext_vector_type(8)));
typedef short s16x4 __attribute__((ext_vector_type(4)));
typedef unsigned u32x4 __attribute__((ext_vector_type(4)));
typedef unsigned u32x2 __attribute__((ext_vector_type(2)));

constexpr int D = 1024, NB = 32, T = 2048, TC = 256, DFF = 2816;
constexpr int MLAT = NB * T, MCTX = NB * TC, MALL = MLAT + MCTX;
constexpr int FW = 4352;
constexpr int GQ = 0, GK = 256, GV = 512, GG = 1024, HQ = 1536, HFF = 2048, HFB = 2560, HI = 3072, HG = 3584, LRF = 4096, LRB = 4112;
constexpr float LN_EPS = 1e-5f, NORM_EPS = 1e-6f;
constexpr float DN_ALPHA = 1.189207115002721f;
constexpr size_t MiB = 1u << 20;
constexpr size_t WS_M = 0, WS_TAB = 2 * MiB, WS_W1IN = 3 * MiB, WS_W1OUT = 14 * MiB, WS_WMIX = 20 * MiB, WS_WMO = 29 * MiB, WS_W2IN = 31 * MiB, WS_W2OUT = 42 * MiB,
                 WS_XC = 48 * MiB, WS_H = 80 * MiB, WS_OB = 224 * MiB, WS_FEAT = 352 * MiB, WS_END = 964 * MiB;
constexpr int LDS_BYTES = 147456;

struct Args {
    const float *x, *c, *ctx, *c_ctx, *w_ada, *b_ada, *ln_gain, *ln_bias, *ffn1_w_in, *ffn1_w_out, *w_mix_in, *a2_f, *a2_b, *abias_f, *abias_b, *lb_logits,
                *gla_gain, *hgrn_gain, *w_mix_out, *ffn2_w_in, *ffn2_w_out;
    float* out; unsigned char* ws; int ph_lo, ph_hi;
};

__device__ __forceinline__ unsigned f2bf(float f) { unsigned u = __builtin_bit_cast(unsigned, f); return (u + 0x7fffu + ((u >> 16) & 1u)) >> 16; }
__device__ __forceinline__ unsigned pk2(float lo, float hi) { return f2bf(lo) | (f2bf(hi) << 16); }
__device__ __forceinline__ float bf2f(unsigned short v) { return __builtin_bit_cast(float, (unsigned)v << 16); }
__device__ __forceinline__ float wave_sum(float v) {
#pragma unroll
    for (int o = 1; o < 64; o <<= 1) v += __shfl_xor(v, o);
    return v;
}
#define LDS_WAIT() asm volatile("s_waitcnt lgkmcnt(0)" ::: "memory")

__device__ __forceinline__ int remap_row(int kind, int n) {
    if (kind == 1) { const int half = n >= DFF ? 1 : 0, j = n - half * DFF; return 256 * (j >> 7) + 128 * half + (j & 127); }
    if (kind == 2) { return n < 1536 ? n : (n < 1568 ? 4096 + (n - 1536) : n - 32); }
    return n;
}
__device__ __forceinline__ void p0_transpose_item(const float* W, int K, int N, bf16* WT, int kind, LAS float* scr, int item, int lane) {
    const int nblk = N / 32, kb = item / nblk, nb = item % nblk, k0 = 64 * kb, n0 = 32 * nb;
    const int r0 = remap_row(kind, n0);
#pragma unroll 8
    for (int i = 0; i < 32; ++i) { const int kk = 2 * i + (lane >> 5); scr[kk * 33 + (lane & 31)] = W[(size_t)(k0 + kk) * N + n0 + (lane & 31)]; }
    LDS_WAIT(); asm volatile("" ::: "memory");
    const int c = lane & 7;
#pragma unroll
    for (int j = 0; j < 4; ++j) { const int n = (lane >> 3) + 8 * j; const LAS float* s = scr + (8 * c) * 33 + n;
        u32x4 o; o.x = pk2(s[0 * 33], s[1 * 33]); o.y = pk2(s[2 * 33], s[3 * 33]); o.z = pk2(s[4 * 33], s[5 * 33]); o.w = pk2(s[6 * 33], s[7 * 33]);
        *(u32x4*)(WT + (size_t)(r0 + n) * K + k0 + 8 * c) = o; }
    LDS_WAIT(); asm volatile("" ::: "memory");
}
__device__ __forceinline__ void p0_prologue(const Args& a, LAS unsigned char* lds) {
    const int tid = threadIdx.x, lane = tid & 63, wave = tid >> 6;
    const int G = gridDim.x, gw = blockIdx.x * 8 + wave, NGW = G * 8;
    unsigned char* ws = a.ws;
    {
        LAS float* scr = (LAS float*)(lds + wave * 16384);
        constexpr int I_IN = (D / 64) * (2 * DFF / 32), I_OUT = (DFF / 64) * (D / 32), I_MIX = (D / 64) * (4128 / 32), I_MO = (D / 64) * (D / 32);
        constexpr int NITEMS = 2 * I_IN + 2 * I_OUT + I_MIX + I_MO;
        for (int it = gw; it < NITEMS; it += NGW) {
            int r = it;
            if (r < I_IN) { p0_transpose_item(a.ffn1_w_in, D, 2 * DFF, (bf16*)(ws + WS_W1IN), 1, scr, r, lane); continue; } r -= I_IN;
            if (r < I_IN) { p0_transpose_item(a.ffn2_w_in, D, 2 * DFF, (bf16*)(ws + WS_W2IN), 1, scr, r, lane); continue; } r -= I_IN;
            if (r < I_OUT) { p0_transpose_item(a.ffn1_w_out, DFF, D, (bf16*)(ws + WS_W1OUT), 0, scr, r, lane); continue; } r -= I_OUT;
            if (r < I_OUT) { p0_transpose_item(a.ffn2_w_out, DFF, D, (bf16*)(ws + WS_W2OUT), 0, scr, r, lane); continue; } r -= I_OUT;
            if (r < I_MIX) { p0_transpose_item(a.w_mix_in, D, 4128, (bf16*)(ws + WS_WMIX), 2, scr, r, lane); continue; } r -= I_MIX;
            p0_transpose_item(a.w_mix_out, D, D, (bf16*)(ws + WS_WMO), 0, scr, r, lane);
        }
        u32x4* z = (u32x4*)((bf16*)(ws + WS_WMIX) + (size_t)4128 * D);
        for (int i = blockIdx.x * 512 + tid; i < 224 * D / 8; i += G * 512) z[i] = (u32x4){0u, 0u, 0u, 0u};
        float* tab = (float*)(ws + WS_TAB);
        for (int i = blockIdx.x * 512 + tid; i < 64 * 256; i += G * 512) { const int p = i >> 8, q = i & 255;
            const float omega = 1.0f / powf(10000.0f, (float)q * (1.0f / 256.0f)); const float ang = (float)p * omega;
            tab[p * 512 + q] = sinf(ang); tab[p * 512 + 256 + q] = cosf(ang); }
    }
    {
        float* oml = (float*)(ws + WS_TAB + 256 * 1024);
        for (int i = blockIdx.x * 512 + tid; i < 1024; i += G * 512) { const int dr = i >> 9, k = i & 511; const float l0 = a.lb_logits[dr * 1024 + k], l1 = a.lb_logits[dr * 1024 + 512 + k];
            oml[i] = 1.0f - 1.0f / (1.0f + expf(l1 - l0)); }
    }
    __syncthreads();
    for (int item = blockIdx.x; item < 9216 / 64; item += G) {
        LAS float* sc = (LAS float*)lds;
        for (int i = tid; i < 33 * 1024; i += 512) { const float v = i < 32 * 1024 ? a.c[i] : a.c_ctx[i - 32 * 1024]; sc[i] = v / (1.0f + __expf(-v)); }
        __syncthreads();
        float acc[33];
#pragma unroll
        for (int b = 0; b < 33; ++b) acc[b] = 0.f;
        const int n = item * 64 + lane;
        for (int k = wave * 128; k < wave * 128 + 128; ++k) { const float wv = a.w_ada[(size_t)k * 9216 + n];
#pragma unroll
            for (int b = 0; b < 33; ++b) acc[b] += sc[b * 1024 + k] * wv; }
        __syncthreads();
        LAS float* red = (LAS float*)lds;
#pragma unroll
        for (int b = 0; b < 33; ++b) red[(wave * 33 + b) * 64 + lane] = acc[b];
        __syncthreads();
        float* mt = (float*)(ws + WS_M);
        for (int i = tid; i < 33 * 64; i += 512) { const int b = i >> 6, l = i & 63; float s = 0.f;
#pragma unroll
            for (int w = 0; w < 8; ++w) s += red[(w * 33 + b) * 64 + l];
            mt[(size_t)b * 9216 + item * 64 + l] = s + a.b_ada[item * 64 + l]; }
        __syncthreads();
    }
}

template <int MODE>
__device__ __forceinline__ void ln_pass(const Args& a, int sub, int li, int nrows) {
    const int tid = threadIdx.x, lane = tid & 63, wave = tid >> 6;
    const int gw = blockIdx.x * 8 + wave, NGW = gridDim.x * 8;
    const float* mt = (const float*)(a.ws + WS_M);
    const float* tab = (const float*)(a.ws + WS_TAB);
    float* xc = (float*)(a.ws + WS_XC);
    bf16* H = (bf16*)(a.ws + WS_H);
    for (int r = gw; r < nrows; r += NGW) {
        const bool lat = r < MLAT; const int b = lat ? (r >> 11) : 32;
        float* Xrow = lat ? a.out + (size_t)r * D : xc + (size_t)(r - MLAT) * D;
        f32x4 v[4];
        if (MODE == 0) {
            const float* src = lat ? a.x + (size_t)r * D : a.ctx + (size_t)(r - MLAT) * D;
#pragma unroll
            for (int j = 0; j < 4; ++j) v[j] = *((const f32x4*)src + lane + 64 * j);
            if (lat) { const int t = r & 2047; const float* tr = tab + (t >> 6) * 512; const float* tcl = tab + (t & 63) * 512;
                v[0] += *((const f32x4*)tr + lane); v[1] += *((const f32x4*)tr + lane + 64); v[2] += *((const f32x4*)tcl + lane); v[3] += *((const f32x4*)tcl + lane + 64); }
#pragma unroll
            for (int j = 0; j < 4; ++j) *((f32x4*)Xrow + lane + 64 * j) = v[j];
        } else {
            float s = 0.f;
#pragma unroll
            for (int j = 0; j < 4; ++j) { v[j] = *((const f32x4*)Xrow + lane + 64 * j); s += (v[j].x + v[j].y) + (v[j].z + v[j].w); }
            const float mean = wave_sum(s) * (1.f / D); float s2 = 0.f;
#pragma unroll
            for (int j = 0; j < 4; ++j) { v[j] = v[j] - mean; s2 += (v[j].x * v[j].x + v[j].y * v[j].y) + (v[j].z * v[j].z + v[j].w * v[j].w); }
            const float rstd = 1.f / sqrtf(wave_sum(s2) * (1.f / D) + LN_EPS);
            const float* gn = a.ln_gain + li * D; const float* bs = a.ln_bias + li * D;
#pragma unroll
            for (int j = 0; j < 4; ++j) { const f32x4 g4 = *((const f32x4*)gn + lane + 64 * j), b4 = *((const f32x4*)bs + lane + 64 * j); v[j] = v[j] * rstd * g4 + b4; *((f32x4*)Xrow + lane + 64 * j) = v[j]; }
        }
        if (MODE != 2) {
            float s = 0.f;
#pragma unroll
            for (int j = 0; j < 4; ++j) s += (v[j].x + v[j].y) + (v[j].z + v[j].w);
            const float mean = wave_sum(s) * (1.f / D); float s2 = 0.f;
#pragma unroll
            for (int j = 0; j < 4; ++j) { v[j] = v[j] - mean; s2 += (v[j].x * v[j].x + v[j].y * v[j].y) + (v[j].z * v[j].z + v[j].w * v[j].w); }
            const float rstd = 1.f / sqrtf(wave_sum(s2) * (1.f / D) + LN_EPS);
            const float* m0 = mt + ((size_t)b * 9 + 3 * sub) * D; const float* m1 = m0 + D;
            u32x2* o8 = (u32x2*)(H + (size_t)r * D) + lane;
#pragma unroll
            for (int j = 0; j < 4; ++j) { const f32x4 s4 = *((const f32x4*)m0 + lane + 64 * j), t4 = *((const f32x4*)m1 + lane + 64 * j);
                const f32x4 h = v[j] * rstd * (s4 + 1.0f) + t4; u32x2 w; w.x = pk2(h.x, h.y); w.y = pk2(h.z, h.w); o8[64 * j] = w; }
        }
    }
}
__device__ __forceinline__ float silu_q(float g) { return g * __builtin_amdgcn_rcpf(1.0f + __expf(-g)); }

#define BAR_LDS() do { asm volatile("s_waitcnt lgkmcnt(0)" ::: "memory"); __builtin_amdgcn_s_barrier(); asm volatile("" ::: "memory"); } while (0)
#define MFMA32(a_, b_, c_) __builtin_amdgcn_mfma_f32_32x32x16_bf16((a_), (b_), (c_), 0, 0, 0)
typedef float f32x2_t __attribute__((ext_vector_type(2)));
typedef __bf16 bf16x2_t __attribute__((ext_vector_type(2)));
__device__ __forceinline__ unsigned cvtpk(float lo, float hi) { f32x2_t v = {lo, hi}; bf16x2_t b = __builtin_convertvector(v, bf16x2_t); return __builtin_bit_cast(unsigned, b); }
__device__ __forceinline__ bf16x8 pack8(const f32x16& x, int s) {
    u32x4 p; p.x = cvtpk(x[8 * s], x[8 * s + 1]); p.y = cvtpk(x[8 * s + 2], x[8 * s + 3]); p.z = cvtpk(x[8 * s + 4], x[8 * s + 5]); p.w = cvtpk(x[8 * s + 6], x[8 * s + 7]);
    return __builtin_bit_cast(bf16x8, p);
}
__device__ __forceinline__ int scan_base(int s, int dir, int b) {
    if (s < 8) return MLAT + b * TC + 32 * (dir ? 7 - s : s);
    return b * T + 32 * (dir ? 63 - (s - 8) : s - 8);
}
__device__ __forceinline__ const bf16* fptr(const bf16* F, int col, size_t row) { return F + ((size_t)(col >> 7) * MALL + row) * 128 + (col & 127); }
template <int DK>
__device__ __forceinline__ void scan_item(const Args& a, LAS unsigned char* lds, const int b, const int head) {
    constexpr bool HGR = (DK == 128);
    constexpr int TPT = DK / 8, NG = 32 / TPT, QS = DK + 8, TS = 40;
    constexpr int VS = 136;
    constexpr int OFF_QD = 0, OFF_KI = OFF_QD + 32 * QS * 2, OFF_KT = OFF_KI + 32 * QS * 2, OFF_VT = OFF_KT + DK * TS * 2, OFF_DEC = OFF_VT + 128 * TS * 2,
                  OFF_CS = OFF_DEC + DK * 4, OFF_SSQ = OFF_CS + NG * DK * 4, OFF_RQ = OFF_SSQ + 512, OFF_RK = OFF_RQ + 32 * QS * 2, OFF_RV = OFF_RK + 32 * QS * 2,
                  OFF_RL = OFF_RV + 32 * VS * 2, DIRB = 67584;
    static_assert(OFF_RL + 32 * 16 * 2 <= DIRB && 2 * DIRB <= LDS_BYTES, "scan LDS map");
    const int tid = threadIdx.x, lane = tid & 63, wave = tid >> 6, dir = wave >> 2, dvq = wave & 3, gt = tid & 255;
    const int l31 = lane & 31, h = lane >> 5;
    LAS unsigned char* L = lds + dir * DIRB;
    LAS bf16* QD = (LAS bf16*)(L + OFF_QD); LAS bf16* KI = (LAS bf16*)(L + OFF_KI); LAS bf16* KT = (LAS bf16*)(L + OFF_KT); LAS bf16* VT = (LAS bf16*)(L + OFF_VT);
    LAS float* DEC = (LAS float*)(L + OFF_DEC); LAS float* CS = (LAS float*)(L + OFF_CS); LAS float* SSQ = (LAS float*)(L + OFF_SSQ);
    LAS bf16* RQ = (LAS bf16*)(L + OFF_RQ); LAS bf16* RK = (LAS bf16*)(L + OFF_RK); LAS bf16* RV = (LAS bf16*)(L + OFF_RV); LAS bf16* RL = (LAS bf16*)(L + OFF_RL);
    const bf16* F = (const bf16*)(a.ws + WS_FEAT);
    bf16* OB = (bf16*)(a.ws + WS_OB); bf16* MG = (bf16*)(a.ws + WS_H);
    const int c = gt % DK, tg = gt / DK;
    const int vn = gt & 127, vth = gt >> 7;
    float lbv = 0.f, abias = 0.f; float a2c[16];
#pragma unroll
    for (int r = 0; r < 16; ++r) a2c[r] = 0.f;
    if (HGR) { const float* lg = a.lb_logits + dir * 1024 + head * 128 + c; lbv = 1.0f / (1.0f + __expf(lg[512] - lg[0])); }
    else { const float* a2 = dir ? a.a2_b : a.a2_f;
#pragma unroll
        for (int r = 0; r < 16; ++r) a2c[r] = a2[r * 256 + head * 64 + c];
        abias = (dir ? a.abias_b : a.abias_f)[head * 64 + c]; }
    const int qcol0 = HGR ? HQ + head * 128 : GQ + head * 64;
    const int kcol0 = HGR ? (dir ? HFB : HFF) + head * 128 : GK + head * 64;
    const int vcol0 = (HGR ? HI : GV) + head * 128;
    const int lrcol = dir ? LRB : LRF;
    const int gcol = (HGR ? HG : GG) + head * 128;
    const int mcol = (HGR ? 512 : 0) + head * 128;
    const float* gain = HGR ? a.hgrn_gain : a.gla_gain;
    const float qscale = HGR ? 0.08838834764831845f : 0.125f;

    f32x4 gnv[4];
#pragma unroll
    for (int g4 = 0; g4 < 4; ++g4) gnv[g4] = *(const f32x4*)(gain + 32 * dvq + 8 * g4 + 4 * h);
    f32x16 S[DK / 32];
#pragma unroll
    for (int t = 0; t < DK / 32; ++t)
#pragma unroll
        for (int r = 0; r < 16; ++r) S[t][r] = 0.f;

    constexpr int NVQ = DK / 64, VPR = DK / 8;
    u32x4 Rq[NVQ], Rk[NVQ], Rv[2], Rl = (u32x4){0u, 0u, 0u, 0u};
#define SCAN_LOAD(s_) do { const int base_ = scan_base((s_), dir, b); \
        _Pragma("unroll") for (int i = 0; i < NVQ; ++i) { const int vid = gt + 256 * i, ti = vid / VPR, cv = vid % VPR; const size_t row = (size_t)(base_ + (dir ? 31 - ti : ti)); \
            Rq[i] = *(const u32x4*)fptr(F, qcol0 + 8 * cv, row); Rk[i] = *(const u32x4*)fptr(F, kcol0 + 8 * cv, row); } \
        _Pragma("unroll") for (int i = 0; i < 2; ++i) { const int vid = gt + 256 * i, ti = vid >> 4, cv = vid & 15; const size_t row = (size_t)(base_ + (dir ? 31 - ti : ti)); \
            Rv[i] = *(const u32x4*)fptr(F, vcol0 + 8 * cv, row); } \
        if (!HGR && gt < 64) { const int ti = gt >> 1; const size_t row = (size_t)(base_ + (dir ? 31 - ti : ti)); Rl = *(const u32x4*)fptr(F, lrcol + 8 * (gt & 1), row); } } while (0)
#define SCAN_STORE_RAW() do { \
        _Pragma("unroll") for (int i = 0; i < NVQ; ++i) { const int vid = gt + 256 * i, ti = vid / VPR, cv = vid % VPR; *(LAS u32x4*)(RQ + ti * QS + 8 * cv) = Rq[i]; *(LAS u32x4*)(RK + ti * QS + 8 * cv) = Rk[i]; } \
        _Pragma("unroll") for (int i = 0; i < 2; ++i) { const int vid = gt + 256 * i, ti = vid >> 4, cv = vid & 15; *(LAS u32x4*)(RV + ti * VS + 8 * cv) = Rv[i]; } \
        if (!HGR && gt < 64) *(LAS u32x4*)(RL + (gt >> 1) * 16 + 8 * (gt & 1)) = Rl; } while (0)
    SCAN_LOAD(0);
    SCAN_STORE_RAW();
    __syncthreads();
    for (int s = 0; s < 72; ++s) {
        const bool is_out = s >= 8, second = s >= 40;
        const int base = scan_base(s, dir, b);
        const size_t orow = (size_t)(base + (dir ? 31 - l31 : l31));
        u32x2 pob[4], pgt[4];
#pragma unroll
        for (int g4 = 0; g4 < 4; ++g4) { pob[g4] = (u32x2){0u, 0u}; pgt[g4] = (u32x2){0u, 0u}; }
        if (is_out && second) {
#pragma unroll
            for (int g4 = 0; g4 < 4; ++g4) { const int vc = 32 * dvq + 8 * g4 + 4 * h;
                pob[g4] = *(const u32x2*)(OB + ((size_t)(mcol >> 7) * MLAT + orow) * 128 + vc); pgt[g4] = *(const u32x2*)fptr(F, gcol + vc, orow); }
        }
        if (s + 1 < 72) SCAN_LOAD(s + 1);
        float bl[TPT], qv[TPT], kv[TPT]; float run = HGR ? 1.f : 0.f;
#pragma unroll
        for (int i = 0; i < TPT; ++i) {
            const int ti = tg * TPT + i;
            const float q = bf2f(RQ[ti * QS + c]), k = bf2f(RK[ti * QS + c]);
            if (HGR) { run *= (1.0f - k); }
            else { float z = abias;
                u32x4 rl[2]; rl[0] = *(const LAS u32x4*)(RL + ti * 16); rl[1] = *(const LAS u32x4*)(RL + ti * 16 + 8);
#pragma unroll
                for (int w = 0; w < 4; ++w) { const unsigned u0 = rl[w >> 1][(w & 1) * 2], u1 = rl[w >> 1][(w & 1) * 2 + 1];
                    z += __builtin_bit_cast(float, u0 << 16) * a2c[4 * w] + __builtin_bit_cast(float, u0 & 0xffff0000u) * a2c[4 * w + 1]
                       + __builtin_bit_cast(float, u1 << 16) * a2c[4 * w + 2] + __builtin_bit_cast(float, u1 & 0xffff0000u) * a2c[4 * w + 3]; }
                run += (fminf(z, 0.f) - __logf(1.0f + __expf(-fabsf(z)))) * 0.0625f; }
            bl[i] = run; qv[i] = q; kv[i] = k;
        }
        CS[tg * DK + c] = run;
        { u32x4 w0, w1; unsigned short rv[16];
#pragma unroll
          for (int i = 0; i < 16; ++i) rv[i] = RV[(16 * vth + i) * VS + vn];
          w0.x = rv[0] | ((unsigned)rv[1] << 16); w0.y = rv[2] | ((unsigned)rv[3] << 16); w0.z = rv[4] | ((unsigned)rv[5] << 16); w0.w = rv[6] | ((unsigned)rv[7] << 16);
          w1.x = rv[8] | ((unsigned)rv[9] << 16); w1.y = rv[10] | ((unsigned)rv[11] << 16); w1.z = rv[12] | ((unsigned)rv[13] << 16); w1.w = rv[14] | ((unsigned)rv[15] << 16);
          *(LAS u32x4*)(VT + vn * TS + 16 * vth) = w0; *(LAS u32x4*)(VT + vn * TS + 16 * vth + 8) = w1; }
        BAR_LDS();
        float prefix = HGR ? 1.f : 0.f, btot = HGR ? 1.f : 0.f;
#pragma unroll
        for (int t = 0; t < NG; ++t) { const float v = CS[t * DK + c]; if (HGR) { btot *= v; if (t < tg) prefix *= v; } else { btot += v; if (t < tg) prefix += v; } }
        const float dec = HGR ? btot : __expf(btot);
        unsigned ktp[TPT / 2];
#pragma unroll
        for (int i = 0; i < TPT; i += 2) {
            const float e0 = HGR ? prefix * bl[i] : __expf(prefix + bl[i]), e1 = HGR ? prefix * bl[i + 1] : __expf(prefix + bl[i + 1]);
            const float ki0 = kv[i] * __builtin_amdgcn_rcpf(e0), ki1 = kv[i + 1] * __builtin_amdgcn_rcpf(e1);
            if (is_out) { const int ti = tg * TPT + i;
                const unsigned wq = cvtpk(qv[i] * e0, qv[i + 1] * e1), wk = cvtpk(ki0, ki1);
                QD[ti * QS + c] = (bf16)(wq & 0xffffu); QD[(ti + 1) * QS + c] = (bf16)(wq >> 16);
                KI[ti * QS + c] = (bf16)(wk & 0xffffu); KI[(ti + 1) * QS + c] = (bf16)(wk >> 16); }
            ktp[i >> 1] = cvtpk(ki0 * dec, ki1 * dec);
        }
#pragma unroll
        for (int i = 0; i < TPT / 8; ++i) { u32x4 w; w.x = ktp[4 * i]; w.y = ktp[4 * i + 1]; w.z = ktp[4 * i + 2]; w.w = ktp[4 * i + 3]; *(LAS u32x4*)(KT + c * TS + tg * TPT + 8 * i) = w; }
        if (tg == 0) DEC[c] = dec;
        BAR_LDS();
        f32x16 OT;
#pragma unroll
        for (int r = 0; r < 16; ++r) OT[r] = 0.f;
        if (is_out) {
            f32x16 accT;
#pragma unroll
            for (int r = 0; r < 16; ++r) accT[r] = 0.f;
#pragma unroll
            for (int s2 = 0; s2 < DK / 16; ++s2) {
                const bf16x8 ka = *(const LAS bf16x8*)(KI + l31 * QS + 16 * s2 + 8 * h);
                const bf16x8 qb = *(const LAS bf16x8*)(QD + l31 * QS + 16 * s2 + 8 * h);
                accT = MFMA32(ka, qb, accT);
            }
#pragma unroll
            for (int r = 0; r < 16; ++r) { const int j = (r & 3) + 8 * (r >> 2) + 4 * h; if (j > l31) accT[r] = 0.f; }
#pragma unroll
            for (int u = 0; u < 2; ++u) {
                const bf16x8 ab = pack8(accT, u);
                const s16x4 lo = *(const LAS s16x4*)(VT + (32 * dvq + l31) * TS + 16 * u + 4 * h);
                const s16x4 hi = *(const LAS s16x4*)(VT + (32 * dvq + l31) * TS + 16 * u + 8 + 4 * h);
                const bf16x8 va = __builtin_shufflevector(lo, hi, 0, 1, 2, 3, 4, 5, 6, 7);
                OT = MFMA32(va, ab, OT);
            }
#pragma unroll
            for (int t = 0; t < DK / 32; ++t)
#pragma unroll
                for (int u = 0; u < 2; ++u) {
                    const bf16x8 sa = pack8(S[t], u);
                    const s16x4 lo = *(const LAS s16x4*)(QD + l31 * QS + 32 * t + 16 * u + 4 * h);
                    const s16x4 hi = *(const LAS s16x4*)(QD + l31 * QS + 32 * t + 16 * u + 8 + 4 * h);
                    const bf16x8 qb = __builtin_shufflevector(lo, hi, 0, 1, 2, 3, 4, 5, 6, 7);
                    OT = MFMA32(sa, qb, OT);
                }
        }
#pragma unroll
        for (int t = 0; t < DK / 32; ++t) {
#pragma unroll
            for (int g4 = 0; g4 < 4; ++g4) { const f32x4 d4 = *(const LAS f32x4*)(DEC + 32 * t + 8 * g4 + 4 * h);
                S[t][4 * g4] *= d4.x; S[t][4 * g4 + 1] *= d4.y; S[t][4 * g4 + 2] *= d4.z; S[t][4 * g4 + 3] *= d4.w; }
#pragma unroll
            for (int u = 0; u < 2; ++u) {
                const bf16x8 ka = *(const LAS bf16x8*)(KT + (32 * t + l31) * TS + 16 * u + 8 * h);
                const bf16x8 vb = *(const LAS bf16x8*)(VT + (32 * dvq + l31) * TS + 16 * u + 8 * h);
                S[t] = MFMA32(ka, vb, S[t]);
            }
        }
        if (is_out) {
            const size_t row = orow;
            if (!second) {
#pragma unroll
                for (int g4 = 0; g4 < 4; ++g4) { u32x2 w; w.x = cvtpk(OT[4 * g4], OT[4 * g4 + 1]); w.y = cvtpk(OT[4 * g4 + 2], OT[4 * g4 + 3]);
                    *(u32x2*)(OB + ((size_t)(mcol >> 7) * MLAT + row) * 128 + 32 * dvq + 8 * g4 + 4 * h) = w; }
            } else {
                float ss = 0.f;
#pragma unroll
                for (int g4 = 0; g4 < 4; ++g4) { const u32x2 w = pob[g4];
                    OT[4 * g4] += __builtin_bit_cast(float, w.x << 16); OT[4 * g4 + 1] += __builtin_bit_cast(float, w.x & 0xffff0000u);
                    OT[4 * g4 + 2] += __builtin_bit_cast(float, w.y << 16); OT[4 * g4 + 3] += __builtin_bit_cast(float, w.y & 0xffff0000u); }
#pragma unroll
                for (int r = 0; r < 16; ++r) ss += OT[r] * OT[r];
                ss += __shfl_xor(ss, 32);
                if (h == 0) SSQ[dvq * 32 + l31] = ss;
                BAR_LDS();
                const float tot = (SSQ[l31] + SSQ[32 + l31]) + (SSQ[64 + l31] + SSQ[96 + l31]);
                const float rs = 1.0f / sqrtf(tot * (1.0f / 128.0f) + NORM_EPS);
#pragma unroll
                for (int g4 = 0; g4 < 4; ++g4) { const int vc = 32 * dvq + 8 * g4 + 4 * h;
                    const u32x2 gw = pgt[g4]; const f32x4 gn = gnv[g4];
                    const float y0 = OT[4 * g4] * rs * gn.x * __builtin_bit_cast(float, gw.x << 16), y1 = OT[4 * g4 + 1] * rs * gn.y * __builtin_bit_cast(float, gw.x & 0xffff0000u);
                    const float y2 = OT[4 * g4 + 2] * rs * gn.z * __builtin_bit_cast(float, gw.y << 16), y3 = OT[4 * g4 + 3] * rs * gn.w * __builtin_bit_cast(float, gw.y & 0xffff0000u);
                    u32x2 w; w.x = cvtpk(y0, y1); w.y = cvtpk(y2, y3);
                    *(u32x2*)(MG + row * D + mcol + vc) = w; }
            }
        }
        if (s + 1 < 72) SCAN_STORE_RAW();
        __syncthreads();
    }
#undef SCAN_LOAD
#undef SCAN_STORE_RAW
}

__global__ void __launch_bounds__(512, 2) mega(Args a) {
    extern __shared__ __attribute__((aligned(16))) unsigned char lds_raw[];
    LAS unsigned char* lds = (LAS unsigned char*)lds_raw;
    cg::grid_group grid = cg::this_grid();
    unsigned char* ws = a.ws;
    const int lo = a.ph_lo, hi = a.ph_hi;
#define IN(k) (lo <= (k) && (k) < hi)
#define SEAM(k) do { if (IN(k) && IN((k) + 1)) grid.sync(); } while (0)
    float* xc = (float*)(ws + WS_XC); const float* mt = (const float*)(ws + WS_M);
    pg8::bf16_t* H = (pg8::bf16_t*)(ws + WS_H); pg8::bf16_t* HID = (pg8::bf16_t*)(ws + WS_FEAT); pg8::bf16_t* FEAT = (pg8::bf16_t*)(ws + WS_FEAT);
    const int G = gridDim.x, cu = blockIdx.x;

    if (IN(0)) p0_prologue(a, lds);
    SEAM(0);
    if (IN(1)) ln_pass<0>(a, 0, 0, MALL);
    SEAM(1);
    if (IN(2)) { pg8::Gemm g{H, (const pg8::bf16_t*)(ws + WS_W1IN), MALL, 2 * DFF, D}; pg8::StaticOrder S; S.init(MALL, 2 * DFF, G, cu);
        pg8::EpiSwiGLU E{HID, DFF}; pg8::gemm_phase<pg8::EpiSwiGLU, pg8::StaticOrder, true, true>(lds, g, S, E); }
    SEAM(2);
    if (IN(3)) { pg8::Gemm g{HID, (const pg8::bf16_t*)(ws + WS_W1OUT), MALL, D, DFF}; pg8::StaticOrder S; S.init(MALL, D, G, cu);
        pg8::EpiResid E{a.out, xc, mt, 2, 0.5f, DN_ALPHA}; pg8::gemm_phase<pg8::EpiResid, pg8::StaticOrder, true, true>(lds, g, S, E); }
    SEAM(3);
    if (IN(4)) ln_pass<1>(a, 1, 0, MALL);
    SEAM(4);
    if (IN(5)) { pg8::Gemm g{H, (const pg8::bf16_t*)(ws + WS_WMIX), MALL, FW, D}; pg8::StaticOrder S; S.init(MALL, FW, G, cu);
        pg8::EpiFeat E{FEAT, MALL, (const float*)(ws + WS_TAB + 256 * 1024)}; pg8::gemm_phase<pg8::EpiFeat, pg8::StaticOrder, true, true>(lds, g, S, E); }
    SEAM(5);
    if (IN(6)) {
        if (cu < 256) { const int item = cu; const int b = item >> 3, grp = (item >> 2) & 1, head = item & 3;
            if (grp) scan_item<128>(a, lds, b, head); else scan_item<64>(a, lds, b, head); }
    }
    SEAM(6);
    if (IN(7)) { pg8::Gemm g{H, (const pg8::bf16_t*)(ws + WS_WMO), MLAT, D, D}; pg8::StaticOrder S; S.init(MLAT, D, G, cu);
        pg8::EpiResid E{a.out, xc, mt, 5, 1.0f, DN_ALPHA}; pg8::gemm_phase<pg8::EpiResid, pg8::StaticOrder, true, true>(lds, g, S, E); }
    SEAM(7);
    if (IN(8)) ln_pass<1>(a, 2, 1, MLAT);
    SEAM(8);
    if (IN(9)) { pg8::Gemm g{H, (const pg8::bf16_t*)(ws + WS_W2IN), MLAT, 2 * DFF, D}; pg8::StaticOrder S; S.init(MLAT, 2 * DFF, G, cu);
        pg8::EpiSwiGLU E{HID, DFF}; pg8::gemm_phase<pg8::EpiSwiGLU, pg8::StaticOrder, true, true>(lds, g, S, E); }
    SEAM(9);
    if (IN(10)) { pg8::Gemm g{HID, (const pg8::bf16_t*)(ws + WS_W2OUT), MLAT, D, DFF}; pg8::StaticOrder S; S.init(MLAT, D, G, cu);
        pg8::EpiResid E{a.out, xc, mt, 8, 0.5f, DN_ALPHA}; pg8::gemm_phase<pg8::EpiResid, pg8::StaticOrder, true, true>(lds, g, S, E); }
    SEAM(10);
    if (IN(11)) ln_pass<2>(a, 0, 2, MLAT);
#undef IN
#undef SEAM
}

extern "C" void kernel_launch(void* const* d_in, const int* in_sizes, int n_in, void* d_out, int out_size, void* d_ws, size_t ws_size, hipStream_t stream) {
    static int grid = 0;
    if (grid == 0) {
        if (n_in != 21 || out_size != MLAT * D || ws_size < WS_END) { fprintf(stderr, "kernel_launch: unexpected shapes: n_in %d out %d ws %zu (need %zu)\n", n_in, out_size, ws_size, (size_t)WS_END); grid = -1; return; }
        int dev = 0, cus = 0, per_cu = 0;
        (void)hipGetDevice(&dev); (void)hipDeviceGetAttribute(&cus, hipDeviceAttributeMultiprocessorCount, dev);
        (void)hipFuncSetAttribute((const void*)mega, hipFuncAttributeMaxDynamicSharedMemorySize, LDS_BYTES);
        (void)hipOccupancyMaxActiveBlocksPerMultiprocessor(&per_cu, (const void*)mega, 512, LDS_BYTES);
        (void)hipGetLastError();
        grid = cus > 0 ? cus : 256; if (grid < 256) fprintf(stderr, "kernel_launch: this kernel needs >= 256 CUs (scan phase: one item per workgroup)\n");
        if (per_cu < 1) fprintf(stderr, "kernel_launch: occupancy query reports %d blocks per CU\n", per_cu);
    }
    if (grid < 0) return;
    Args a{};
    const float** p = (const float**)&a;
    for (int i = 0; i < 21; ++i) p[i] = (const float*)d_in[i];
    a.out = (float*)d_out; a.ws = (unsigned char*)d_ws; a.ph_lo = 0; a.ph_hi = 12;
    void* args[] = {&a};
    hipError_t e = hipLaunchCooperativeKernel((void*)mega, dim3(grid), dim3(512), args, LDS_BYTES, stream);
    if (e != hipSuccess) fprintf(stderr, "cooperative launch failed: %s (grid %d)\n", hipGetErrorString(e), grid);
}
```

```cpp
#include <hip/hip_runtime.h>
#include <hip/hip_cooperative_groups.h>
#include <cstdio>
#include <cstdint>
namespace cg = cooperative_groups;
namespace pg8 {
#define PG8_LAS __attribute__((address_space(3)))
typedef unsigned short bf16_t;
typedef short bf16x8 __attribute__((ext_vector_type(8)));
typedef float f32x4 __attribute__((ext_vector_type(4)));
typedef unsigned u32x4 __attribute__((ext_vector_type(4)));
constexpr int BM = 256, BK = 64, HALF = 128, HTB = HALF * BK * 2  , STAGE_BYTES = 8 * HTB, NXCD = 8, WGM = 8;

__host__ __device__ __forceinline__ int lds_byte(int r, int c) { const int st = (r >> 4) * 2 + (c >> 5), rr = r & 15, cc = c & 31, ob = rr * 64 + cc * 2; return st * 1024 + (ob ^ (((ob >> 9) & 1) << 5)); }
__host__ __device__ __forceinline__ void stage_rc(int b, int& R, int& C) { const int st = b / 1024, sb = b % 1024, swz = sb ^ (((sb >> 9) & 1) << 5); R = (st >> 1) * 16 + swz / 64; C = (st & 1) * 32 + (swz % 64) / 2; }
__host__ __device__ __forceinline__ int perm32(int rho) { const int n = rho >> 4, i = rho & 15; return 8 * (i >> 2) + 4 * n + (i & 3); }

struct Unit { int pm, pn; };
struct Gemm { const bf16_t* A; const bf16_t* Bt; int M, N, K; };

struct StaticOrder {
    int nM, nN, nwg, G, c;
    __host__ __device__ void init(int M, int N, int G_, int c_) { nM = M / BM; nN = N / BM; nwg = nM * nN; G = G_; c = c_; }
    __host__ __device__ bool next(int i, Unit& u) const {
        const long L = (long)i * G + c; if (L >= nwg) return false;
        int wgid = (int)L; { const int q = nwg / NXCD, r = nwg % NXCD, xcd = wgid % NXCD, off = wgid / NXCD; wgid = (xcd < r ? xcd * (q + 1) : r * (q + 1) + (xcd - r) * q) + off; }
        const int nig = WGM * nN, gid = wgid / nig, fm = gid * WGM, gsz = (nM - fm) < WGM ? (nM - fm) : WGM;
        u.pm = fm + ((wgid % nig) % gsz); u.pn = (wgid % nig) / gsz; return true;
    }
    __device__ __forceinline__ void a_ready(const Unit&) const {}
    __device__ __forceinline__ void done(const Unit&) const {}
};

__device__ __forceinline__ unsigned cvt_pk_bf16(float lo, float hi) { unsigned r; asm volatile("v_cvt_pk_bf16_f32 %0, %1, %2" : "=v"(r) : "v"(lo), "v"(hi)); return r; }
typedef float f32x2 __attribute__((ext_vector_type(2)));
__device__ __forceinline__ float silu_f(float g) { return g * __builtin_amdgcn_rcpf(1.0f + __builtin_amdgcn_exp2f(-1.44269504089f * g)); }
struct EpiBf16Plain {
    static constexpr bool PERM = true, AFTER_DRAIN = false;
    bf16_t* O; int ldc;
    __device__ __forceinline__ void operator()(const f32x4 (&acc)[2][2][4][2], const Unit& u, int wr, int wc, int fr, int fq) const {
        const int row0 = u.pm * BM + wr * 64 + fr; const int col0 = u.pn * BM + wc * 32 + 8 * fq;
#pragma unroll
        for (int ai = 0; ai < 2; ++ai)
#pragma unroll
            for (int m = 0; m < 4; ++m) { bf16_t* rowp = O + (size_t)(row0 + ai * HALF + m * 16) * ldc + col0;
#pragma unroll
                for (int bj = 0; bj < 2; ++bj) { const f32x4 v0 = acc[ai][bj][m][0], v1 = acc[ai][bj][m][1];
                    u32x4 w; w.x = cvt_pk_bf16(v0[0], v0[1]); w.y = cvt_pk_bf16(v0[2], v0[3]); w.z = cvt_pk_bf16(v1[0], v1[1]); w.w = cvt_pk_bf16(v1[2], v1[3]);
                    *(u32x4*)(rowp + bj * HALF) = w; } }
    }
};
struct EpiBf16Blk {
    static constexpr bool PERM = true, AFTER_DRAIN = false;
    bf16_t* O; int Mrows;
    __device__ __forceinline__ void operator()(const f32x4 (&acc)[2][2][4][2], const Unit& u, int wr, int wc, int fr, int fq) const {
        const int row0 = u.pm * BM + wr * 64 + fr; const int col0 = wc * 32 + 8 * fq;
#pragma unroll
        for (int ai = 0; ai < 2; ++ai)
#pragma unroll
            for (int m = 0; m < 4; ++m) {
#pragma unroll
                for (int bj = 0; bj < 2; ++bj) { const f32x4 v0 = acc[ai][bj][m][0], v1 = acc[ai][bj][m][1];
                    u32x4 w; w.x = cvt_pk_bf16(v0[0], v0[1]); w.y = cvt_pk_bf16(v0[2], v0[3]); w.z = cvt_pk_bf16(v1[0], v1[1]); w.w = cvt_pk_bf16(v1[2], v1[3]);
                    *(u32x4*)(O + ((size_t)(2 * u.pn + bj) * Mrows + (row0 + ai * HALF + m * 16)) * 128 + col0) = w; } }
    }
};
struct EpiFeat {
    static constexpr bool PERM = true, AFTER_DRAIN = false;
    bf16_t* O; int Mrows; const float* oml;
    __device__ __forceinline__ void operator()(const f32x4 (&acc)[2][2][4][2], const Unit& u, int wr, int wc, int fr, int fq) const {
        const int row0 = u.pm * BM + wr * 64 + fr + (u.pm < 256 ? (u.pm >> 3) * 36 : 1152); const int col0 = wc * 32 + 8 * fq; const int pn = u.pn;
        const int mode = pn == 0 ? 1 : ((pn == 6 || pn == 7) ? 2 : ((pn >= 8 && pn <= 11) ? 3 : ((pn == 4 || pn == 5 || pn == 14 || pn == 15) ? 4 : 0)));
        const float* omp = oml + (pn >= 10 ? 512 : 0) + (pn & 1) * 256 + col0;
#pragma unroll
        for (int ai = 0; ai < 2; ++ai)
#pragma unroll
            for (int m = 0; m < 4; ++m) {
#pragma unroll
                for (int bj = 0; bj < 2; ++bj) { f32x4 v0 = acc[ai][bj][m][0], v1 = acc[ai][bj][m][1];
                    if (mode == 1) { v0 = v0 * 0.125f; v1 = v1 * 0.125f; }
                    else if (mode == 2) {
#pragma unroll
                        for (int e = 0; e < 4; ++e) { v0[e] = silu_f(v0[e]) * 0.08838834764831845f; v1[e] = silu_f(v1[e]) * 0.08838834764831845f; } }
                    else if (mode == 4) {
#pragma unroll
                        for (int e = 0; e < 4; ++e) { v0[e] = silu_f(v0[e]); v1[e] = silu_f(v1[e]); } }
                    else if (mode == 3) { const f32x4 o0 = *(const f32x4*)(omp + bj * HALF), o1 = *(const f32x4*)(omp + bj * HALF + 4);
#pragma unroll
                        for (int e = 0; e < 4; ++e) { v0[e] = o0[e] * __builtin_amdgcn_rcpf(1.0f + __builtin_amdgcn_exp2f(1.44269504089f * v0[e]));
                                                      v1[e] = o1[e] * __builtin_amdgcn_rcpf(1.0f + __builtin_amdgcn_exp2f(1.44269504089f * v1[e])); } }
                    u32x4 w; w.x = cvt_pk_bf16(v0[0], v0[1]); w.y = cvt_pk_bf16(v0[2], v0[3]); w.z = cvt_pk_bf16(v1[0], v1[1]); w.w = cvt_pk_bf16(v1[2], v1[3]);
                    *(u32x4*)(O + ((size_t)(2 * pn + bj) * Mrows + (row0 + ai * HALF + m * 16)) * 128 + col0) = w; } }
    }
};
struct EpiSwiGLU {
    static constexpr bool PERM = true, AFTER_DRAIN = false;
    bf16_t* O; int ldc;
    __device__ __forceinline__ void operator()(const f32x4 (&acc)[2][2][4][2], const Unit& u, int wr, int wc, int fr, int fq) const {
        const int row0 = u.pm * BM + wr * 64 + fr; const int col0 = u.pn * HALF + wc * 32 + 8 * fq;
#pragma unroll
        for (int ai = 0; ai < 2; ++ai)
#pragma unroll
            for (int m = 0; m < 4; ++m) { bf16_t* rowp = O + (size_t)(row0 + ai * HALF + m * 16) * ldc + col0;
                const f32x4 g0 = acc[ai][0][m][0], g1 = acc[ai][0][m][1], u0 = acc[ai][1][m][0], u1 = acc[ai][1][m][1];
                u32x4 w;
                w.x = cvt_pk_bf16(silu_f(g0[0]) * u0[0], silu_f(g0[1]) * u0[1]); w.y = cvt_pk_bf16(silu_f(g0[2]) * u0[2], silu_f(g0[3]) * u0[3]);
                w.z = cvt_pk_bf16(silu_f(g1[0]) * u1[0], silu_f(g1[1]) * u1[1]); w.w = cvt_pk_bf16(silu_f(g1[2]) * u1[2], silu_f(g1[3]) * u1[3]);
                *(u32x4*)rowp = w; }
    }
};
struct EpiResid {
    static constexpr bool PERM = false, AFTER_DRAIN = false;
    float* Xlat; float* Xctx; const float* mtab; int gate_idx; float w; float alpha; const float* srcLat; const float* srcCtx; const float* tab;
    const float* stats; const float* lng; const float* lnb;
    __device__ __forceinline__ void operator()(const f32x4 (&acc)[2][2][4][2], const Unit& u, int wr, int wc, int fr, int fq) const {
        const bool lat = u.pm < 256; const int b = lat ? (u.pm >> 3) : 32;
        const float* g = mtab + ((size_t)b * 9 + gate_idx) * 1024;
        const size_t toff = lat ? (size_t)u.pm * BM * 1024 : (size_t)(u.pm - 256) * BM * 1024;
        float* X = (lat ? Xlat : Xctx) + toff;
        const float* R = srcLat ? (lat ? srcLat : srcCtx) + toff : X;
        const bool addpos = srcLat != nullptr && lat;
        const int col0 = u.pn * BM + wc * 32 + 4 * fq;
#pragma unroll
        for (int bj = 0; bj < 2; ++bj)
#pragma unroll
            for (int n = 0; n < 2; ++n) { const int col = col0 + bj * HALF + n * 16; f32x4 gv = *(const f32x4*)(g + col); gv = gv * w;
                f32x4 lg4 = (f32x4){1.f, 1.f, 1.f, 1.f}, lb4 = (f32x4){0.f, 0.f, 0.f, 0.f};
                if (stats) { lg4 = *(const f32x4*)(lng + col); lb4 = *(const f32x4*)(lnb + col); }
#pragma unroll
                for (int ai = 0; ai < 2; ++ai)
#pragma unroll
                    for (int m = 0; m < 4; ++m) { const int rl = ai * HALF + wr * 64 + m * 16 + fr;
                        f32x4 xv = *(const f32x4*)(R + (size_t)rl * 1024 + col);
                        if (stats) { const f32x2 st = *(const f32x2*)(stats + 2 * ((size_t)u.pm * BM + rl)); xv = (xv - st.x) * st.y * lg4 + lb4; }
                        if (addpos) { const int t = (u.pm * BM + rl) & 2047; xv += *(const f32x4*)(tab + (u.pn < 2 ? (t >> 6) * 512 + col : (t & 63) * 512 + col - 512)); }
                        *(f32x4*)(X + (size_t)rl * 1024 + col) = xv * alpha + gv * acc[ai][bj][m][n]; } }
    }
};
template <class Epi, class Sched, bool ALIGN_EPI = false, bool SP2 = false>
__device__ __forceinline__ void gemm_phase(PG8_LAS unsigned char* lds, const Gemm g, const Sched& S, const Epi& E) {
    const int tid = threadIdx.x, wid = __builtin_amdgcn_readfirstlane(tid >> 6), lane = tid & 63, wr = wid >> 2, wc = wid & 3, fr = lane & 15, fq = lane >> 4;
    const int K = g.K, nt = K / BK;
    unsigned voffA[2], voffB[2];
#pragma unroll
    for (int i = 0; i < 2; ++i) { int R, C; stage_rc(tid * 16 + i * 8192, R, C); const int Rb = Epi::PERM ? ((R & ~31) + perm32(R & 31)) : R;
        voffA[i] = (unsigned)(R * K + C) * 2u; voffB[i] = (unsigned)(Rb * K + C) * 2u; }
    const size_t kstep = (size_t)(BK * 2);
    const size_t hstep = (size_t)HALF * K * 2;
    const size_t tstep = 2 * hstep;
    const unsigned ldsw = (unsigned)wid * 1024u;
    const int aoff = lds_byte(wr * 64 + fr, fq * 8), boff = lds_byte(wc * 32 + fr, fq * 8);
#define PG8_SA(b, h) (((b) * 2 + (h)) * HTB)
#define PG8_SB(b, h) ((4 + (b) * 2 + (h)) * HTB)
#define PG8_STAGE(bufoff, gbase, voff) do { _Pragma("unroll") for (int _i = 0; _i < 2; ++_i) \
        __builtin_amdgcn_global_load_lds((const unsigned*)((const char*)(gbase) + (voff)[_i]), (PG8_LAS unsigned*)(lds + (bufoff) + ldsw + _i * 8192), 16, 0, 0); } while (0)
#define PG8_LDA(dst, b, h) do { _Pragma("unroll") for (int m = 0; m < 4; ++m) _Pragma("unroll") for (int k = 0; k < 2; ++k) dst[m][k] = *(const PG8_LAS bf16x8*)(lds + PG8_SA(b, h) + aoff + m * 2048 + k * 1024); } while (0)
#define PG8_LDB(dst, b, h) do { _Pragma("unroll") for (int n = 0; n < 2; ++n) _Pragma("unroll") for (int k = 0; k < 2; ++k) dst[n][k] = *(const PG8_LAS bf16x8*)(lds + PG8_SB(b, h) + boff + n * 2048 + k * 1024); } while (0)
#define PG8_MMA(ai, bj, At, Bt) do { __builtin_amdgcn_s_setprio(1); _Pragma("unroll") for (int m = 0; m < 4; ++m) _Pragma("unroll") for (int n = 0; n < 2; ++n) _Pragma("unroll") for (int k = 0; k < 2; ++k) \
        acc[ai][bj][m][n] = __builtin_amdgcn_mfma_f32_16x16x32_bf16(Bt[n][k], At[m][k], acc[ai][bj][m][n], 0, 0, 0); __builtin_amdgcn_s_setprio(0); } while (0)
#define PG8_WAIT_V(n) asm volatile("s_waitcnt vmcnt(" #n ")" ::: "memory")
#define PG8_WAIT_L(n) asm volatile("s_waitcnt lgkmcnt(" #n ")" ::: "memory")
#define PG8_BAR __builtin_amdgcn_s_barrier()
#define PG8_SCHED __builtin_amdgcn_sched_barrier(0)
    Unit cur, nxt; int ui = 0;
    if (!S.next(0, cur)) return;
    f32x4 acc[2][2][4][2];
#pragma unroll
    for (int a = 0; a < 2; ++a)
#pragma unroll
        for (int b = 0; b < 2; ++b)
#pragma unroll
            for (int m = 0; m < 4; ++m)
#pragma unroll
                for (int n = 0; n < 2; ++n) acc[a][b][m][n] = (f32x4){0.f, 0.f, 0.f, 0.f};
    bf16x8 At[4][2], B0[2][2], B1[2][2];
    const char* cA = (const char*)g.A + (size_t)cur.pm * tstep; const char* cB = (const char*)g.Bt + (size_t)cur.pn * tstep;
    S.a_ready(cur);
    if constexpr (SP2) {
        PG8_STAGE(PG8_SB(0, 0), cB, voffB); PG8_STAGE(PG8_SB(0, 1), cB + hstep, voffB); PG8_STAGE(PG8_SA(0, 0), cA, voffA); PG8_STAGE(PG8_SA(0, 1), cA + hstep, voffA);
        if (wr == 1) PG8_BAR;
        PG8_WAIT_V(2); PG8_BAR;
        PG8_STAGE(PG8_SB(1, 0), cB + kstep, voffB); PG8_STAGE(PG8_SA(1, 0), cA + kstep, voffA); PG8_STAGE(PG8_SB(1, 1), cB + hstep + kstep, voffB);
        PG8_WAIT_V(6); PG8_BAR;
    } else {
        PG8_STAGE(PG8_SB(0, 0), cB, voffB); PG8_STAGE(PG8_SA(0, 0), cA, voffA); PG8_STAGE(PG8_SB(0, 1), cB + hstep, voffB); PG8_STAGE(PG8_SA(0, 1), cA + hstep, voffA);
        if (wr == 1) PG8_BAR;
        PG8_WAIT_V(4); PG8_BAR;
        PG8_STAGE(PG8_SB(1, 0), cB + kstep, voffB); PG8_STAGE(PG8_SA(1, 0), cA + kstep, voffA); PG8_STAGE(PG8_SB(1, 1), cB + hstep + kstep, voffB);
        PG8_WAIT_V(6); PG8_BAR;
    }
    for (;;) {
        const bool has_next = S.next(ui + 1, nxt);
        const char* nA = has_next ? (const char*)g.A + (size_t)nxt.pm * tstep : cA; const char* nB = has_next ? (const char*)g.Bt + (size_t)nxt.pn * tstep : cB;
        for (int t = 0; t < nt; t += 2) {
            const bool last = (t == nt - 2);
            const char* a1 = cA + (size_t)(t + 1) * kstep;
            const char* a2 = last ? nA : cA + (size_t)(t + 2) * kstep; const char* b2 = last ? nB : cB + (size_t)(t + 2) * kstep;
            const char* a3 = a2 + kstep; const char* b3 = b2 + kstep;
            if (last && has_next) S.a_ready(nxt);
            if constexpr (SP2) {
            PG8_LDB(B0, 0, 0); PG8_LDB(B1, 0, 1); PG8_SCHED; PG8_LDA(At, 0, 0); PG8_STAGE(PG8_SA(1, 1), a1 + hstep, voffA);
            PG8_WAIT_V(8); PG8_WAIT_L(0); PG8_BAR; PG8_MMA(0, 0, At, B0); PG8_MMA(0, 1, At, B1); PG8_BAR; PG8_SCHED;
            PG8_LDA(At, 0, 1); PG8_STAGE(PG8_SB(0, 0), b2, voffB); PG8_STAGE(PG8_SB(0, 1), b2 + hstep, voffB); PG8_STAGE(PG8_SA(0, 0), a2, voffA);
            PG8_WAIT_V(8); PG8_WAIT_L(0); PG8_BAR; PG8_MMA(1, 0, At, B0); PG8_MMA(1, 1, At, B1); PG8_BAR; PG8_SCHED;
            PG8_LDB(B0, 1, 0); PG8_LDB(B1, 1, 1); PG8_SCHED; PG8_LDA(At, 1, 0); PG8_STAGE(PG8_SA(0, 1), a2 + hstep, voffA);
            PG8_WAIT_V(8); PG8_WAIT_L(0); PG8_BAR; PG8_MMA(0, 0, At, B0); PG8_MMA(0, 1, At, B1); PG8_BAR; PG8_SCHED;
            PG8_LDA(At, 1, 1); PG8_STAGE(PG8_SB(1, 0), b3, voffB); PG8_STAGE(PG8_SB(1, 1), b3 + hstep, voffB); PG8_STAGE(PG8_SA(1, 0), a3, voffA);
            PG8_WAIT_V(8); PG8_WAIT_L(0); PG8_BAR; PG8_MMA(1, 0, At, B0); PG8_MMA(1, 1, At, B1); PG8_BAR; PG8_SCHED;
            } else {
            PG8_LDB(B0, 0, 0); PG8_SCHED; PG8_LDA(At, 0, 0); PG8_STAGE(PG8_SA(1, 1), a1 + hstep, voffA);
            PG8_WAIT_L(8); PG8_BAR; PG8_WAIT_L(0); PG8_MMA(0, 0, At, B0); PG8_BAR; PG8_SCHED;
            PG8_LDB(B1, 0, 1); PG8_STAGE(PG8_SB(0, 0), b2, voffB);
            PG8_BAR; PG8_WAIT_L(0); PG8_MMA(0, 1, At, B1); PG8_BAR;
            PG8_LDA(At, 0, 1); PG8_STAGE(PG8_SA(0, 0), a2, voffA);
            PG8_BAR; PG8_WAIT_L(0); PG8_MMA(1, 0, At, B0); PG8_BAR; PG8_SCHED;
            PG8_STAGE(PG8_SB(0, 1), b2 + hstep, voffB);
            PG8_WAIT_V(6); PG8_BAR; PG8_MMA(1, 1, At, B1); PG8_BAR;
            PG8_LDB(B0, 1, 0); PG8_SCHED; PG8_LDA(At, 1, 0); PG8_STAGE(PG8_SA(0, 1), a2 + hstep, voffA);
            PG8_WAIT_L(8); PG8_BAR; PG8_WAIT_L(0); PG8_MMA(0, 0, At, B0); PG8_BAR; PG8_SCHED;
            PG8_LDB(B1, 1, 1); PG8_STAGE(PG8_SB(1, 0), b3, voffB);
            PG8_BAR; PG8_WAIT_L(0); PG8_MMA(0, 1, At, B1); PG8_BAR;
            PG8_LDA(At, 1, 1); PG8_STAGE(PG8_SA(1, 0), a3, voffA);
            PG8_BAR; PG8_WAIT_L(0); PG8_MMA(1, 0, At, B0); PG8_BAR; PG8_SCHED;
            PG8_STAGE(PG8_SB(1, 1), b3 + hstep, voffB);
            PG8_WAIT_V(6); PG8_BAR; PG8_MMA(1, 1, At, B1); PG8_BAR;
            }
        }
        if constexpr (ALIGN_EPI) { if (wr == 0) PG8_BAR; }
        if constexpr (!Epi::AFTER_DRAIN) { E(acc, cur, wr, wc, fr, fq); S.done(cur); }
        if (!has_next) break;
#pragma unroll
        for (int a = 0; a < 2; ++a)
#pragma unroll
            for (int b = 0; b < 2; ++b)
#pragma unroll
                for (int m = 0; m < 4; ++m)
#pragma unroll
                    for (int n = 0; n < 2; ++n) acc[a][b][m][n] = (f32x4){0.f, 0.f, 0.f, 0.f};
        cur = nxt; cA = nA; cB = nB; ++ui;
        if constexpr (ALIGN_EPI) { if (wr == 1) PG8_BAR; }
    }
    PG8_WAIT_V(0);
    if constexpr (!ALIGN_EPI) { if (wr == 0) PG8_BAR; }
    PG8_BAR;
    if constexpr (Epi::AFTER_DRAIN) { E.fused(acc, cur, wr, wc, fr, fq, lds, wid, lane); S.done(cur); }
#undef PG8_SA
#undef PG8_SB
#undef PG8_STAGE
#undef PG8_LDA
#undef PG8_LDB
#undef PG8_MMA
#undef PG8_WAIT_V
#undef PG8_WAIT_L
#undef PG8_BAR
#undef PG8_SCHED
}
}

#define LAS __attribute__((address_space(3)))
typedef unsigned short bf16;
typedef float f32x4 __attribute__((ext_vector_type(4)));
typedef float f32x16 __attribute__((ext_vector_type(16)));
typedef short bf16x8 __attribute__((ext_vector_type(8)));
typedef short s16x4 __attribute__((ext_vector_type(4)));
typedef unsigned u32x4 __attribute__((ext_vector_type(4)));
typedef unsigned u32x2 __attribute__((ext_vector_type(2)));

constexpr int D = 1024, NB = 32, T = 2048, TC = 256, DFF = 2816;
constexpr int MLAT = NB * T, MCTX = NB * TC, MALL = MLAT + MCTX;
constexpr int FMROWS = 75008;
constexpr int FW = 4352;
constexpr int GQ = 0, GK = 256, GV = 512, GG = 1024, HQ = 1536, HFF = 2048, HFB = 2560, HI = 3072, HG = 3584, LRF = 4096, LRB = 4112;
constexpr float LN_EPS = 1e-5f, NORM_EPS = 1e-6f;
constexpr float DN_ALPHA = 1.189207115002721f;
constexpr size_t MiB = 1u << 20;
constexpr size_t WS_M = 0, WS_TAB = 2 * MiB, WS_W1IN = 3 * MiB, WS_W1OUT = 14 * MiB, WS_WMIX = 20 * MiB, WS_WMO = 29 * MiB, WS_W2IN = 31 * MiB, WS_W2OUT = 42 * MiB,
                 WS_XC = 48 * MiB, WS_H = 80 * MiB, WS_OB = 224 * MiB, WS_FEAT = 352 * MiB, WS_END = 976 * MiB;
constexpr size_t WS_STATS = WS_TAB + 384 * 1024;
constexpr int LDS_BYTES = 147456;

struct Args {
    const float *x, *c, *ctx, *c_ctx, *w_ada, *b_ada, *ln_gain, *ln_bias, *ffn1_w_in, *ffn1_w_out, *w_mix_in, *a2_f, *a2_b, *abias_f, *abias_b, *lb_logits,
                *gla_gain, *hgrn_gain, *w_mix_out, *ffn2_w_in, *ffn2_w_out;
    float* out; unsigned char* ws; int ph_lo, ph_hi;
};

__device__ __forceinline__ unsigned f2bf(float f) { unsigned u = __builtin_bit_cast(unsigned, f); return (u + 0x7fffu + ((u >> 16) & 1u)) >> 16; }
__device__ __forceinline__ unsigned pk2(float lo, float hi) { return f2bf(lo) | (f2bf(hi) << 16); }
__device__ __forceinline__ float bf2f(unsigned short v) { return __builtin_bit_cast(float, (unsigned)v << 16); }
__device__ __forceinline__ float wave_sum(float v) {
#pragma unroll
    for (int o = 1; o < 64; o <<= 1) v += __shfl_xor(v, o);
    return v;
}
#define LDS_WAIT() asm volatile("s_waitcnt lgkmcnt(0)" ::: "memory")

__device__ __forceinline__ int remap_row(int kind, int n) {
    if (kind == 1) { const int half = n >= DFF ? 1 : 0, j = n - half * DFF; return 256 * (j >> 7) + 128 * half + (j & 127); }
    if (kind == 2) { return n < 1536 ? n : (n < 1568 ? 4096 + (n - 1536) : n - 32); }
    return n;
}
__device__ __forceinline__ void p0_transpose_item(const float* W, int K, int N, bf16* WT, int kind, LAS float* scr, int item, int lane) {
    const int nblk = N / 32, kb = item / nblk, nb = item % nblk, k0 = 64 * kb, n0 = 32 * nb;
    const int r0 = remap_row(kind, n0);
#pragma unroll 8
    for (int i = 0; i < 32; ++i) { const int kk = 2 * i + (lane >> 5); scr[kk * 33 + (lane & 31)] = W[(size_t)(k0 + kk) * N + n0 + (lane & 31)]; }
    LDS_WAIT(); asm volatile("" ::: "memory");
    const int c = lane & 7;
#pragma unroll
    for (int j = 0; j < 4; ++j) { const int n = (lane >> 3) + 8 * j; const LAS float* s = scr + (8 * c) * 33 + n;
        u32x4 o; o.x = pk2(s[0 * 33], s[1 * 33]); o.y = pk2(s[2 * 33], s[3 * 33]); o.z = pk2(s[4 * 33], s[5 * 33]); o.w = pk2(s[6 * 33], s[7 * 33]);
        *(u32x4*)(WT + (size_t)(r0 + n) * K + k0 + 8 * c) = o; }
    LDS_WAIT(); asm volatile("" ::: "memory");
}
__device__ __forceinline__ void p0_prologue(const Args& a, LAS unsigned char* lds) {
    const int tid = threadIdx.x, lane = tid & 63, wave = tid >> 6;
    const int G = gridDim.x, gw = blockIdx.x * 8 + wave, NGW = G * 8;
    unsigned char* ws = a.ws;
    {
        LAS float* scr = (LAS float*)(lds + wave * 16384);
        constexpr int I_IN = (D / 64) * (2 * DFF / 32), I_OUT = (DFF / 64) * (D / 32), I_MIX = (D / 64) * (4128 / 32), I_MO = (D / 64) * (D / 32);
        constexpr int NITEMS = 2 * I_IN + 2 * I_OUT + I_MIX + I_MO;
        for (int it = gw; it < NITEMS; it += NGW) {
            int r = it;
            if (r < I_IN) { p0_transpose_item(a.ffn1_w_in, D, 2 * DFF, (bf16*)(ws + WS_W1IN), 1, scr, r, lane); continue; } r -= I_IN;
            if (r < I_IN) { p0_transpose_item(a.ffn2_w_in, D, 2 * DFF, (bf16*)(ws + WS_W2IN), 1, scr, r, lane); continue; } r -= I_IN;
            if (r < I_OUT) { p0_transpose_item(a.ffn1_w_out, DFF, D, (bf16*)(ws + WS_W1OUT), 0, scr, r, lane); continue; } r -= I_OUT;
            if (r < I_OUT) { p0_transpose_item(a.ffn2_w_out, DFF, D, (bf16*)(ws + WS_W2OUT), 0, scr, r, lane); continue; } r -= I_OUT;
            if (r < I_MIX) { p0_transpose_item(a.w_mix_in, D, 4128, (bf16*)(ws + WS_WMIX), 2, scr, r, lane); continue; } r -= I_MIX;
            p0_transpose_item(a.w_mix_out, D, D, (bf16*)(ws + WS_WMO), 0, scr, r, lane);
        }
        u32x4* z = (u32x4*)((bf16*)(ws + WS_WMIX) + (size_t)4128 * D);
        for (int i = blockIdx.x * 512 + tid; i < 224 * D / 8; i += G * 512) z[i] = (u32x4){0u, 0u, 0u, 0u};
        float* tab = (float*)(ws + WS_TAB);
        for (int i = blockIdx.x * 512 + tid; i < 64 * 256; i += G * 512) { const int p = i >> 8, q = i & 255;
            const float omega = 1.0f / powf(10000.0f, (float)q * (1.0f / 256.0f)); const float ang = (float)p * omega;
            tab[p * 512 + q] = sinf(ang); tab[p * 512 + 256 + q] = cosf(ang); }
    }
    {
        float* oml = (float*)(ws + WS_TAB + 256 * 1024);
        for (int i = blockIdx.x * 512 + tid; i < 1024; i += G * 512) { const int dr = i >> 9, k = i & 511; const float l0 = a.lb_logits[dr * 1024 + k], l1 = a.lb_logits[dr * 1024 + 512 + k];
            oml[i] = 1.0f - 1.0f / (1.0f + expf(l1 - l0)); }
    }
    __syncthreads();
    for (int item = blockIdx.x; item < 9216 / 64; item += G) {
        LAS float* sc = (LAS float*)lds;
        for (int i = tid; i < 33 * 1024; i += 512) { const float v = i < 32 * 1024 ? a.c[i] : a.c_ctx[i - 32 * 1024]; sc[i] = v / (1.0f + __expf(-v)); }
        __syncthreads();
        float acc[33];
#pragma unroll
        for (int b = 0; b < 33; ++b) acc[b] = 0.f;
        const int n = item * 64 + lane;
        for (int k = wave * 128; k < wave * 128 + 128; ++k) { const float wv = a.w_ada[(size_t)k * 9216 + n];
#pragma unroll
            for (int b = 0; b < 33; ++b) acc[b] += sc[b * 1024 + k] * wv; }
        __syncthreads();
        LAS float* red = (LAS float*)lds;
#pragma unroll
        for (int b = 0; b < 33; ++b) red[(wave * 33 + b) * 64 + lane] = acc[b];
        __syncthreads();
        float* mt = (float*)(ws + WS_M);
        for (int i = tid; i < 33 * 64; i += 512) { const int b = i >> 6, l = i & 63; float s = 0.f;
#pragma unroll
            for (int w = 0; w < 8; ++w) s += red[(w * 33 + b) * 64 + l];
            mt[(size_t)b * 9216 + item * 64 + l] = s + a.b_ada[item * 64 + l]; }
        __syncthreads();
    }
}

template <int MODE>
__device__ __forceinline__ void ln_load(const Args& a, int r, int lane, f32x4 (&v)[4]) {
    const bool lat = r < MLAT;
    if (MODE == 0) {
        const float* src = lat ? a.x + (size_t)r * D : a.ctx + (size_t)(r - MLAT) * D;
#pragma unroll
        for (int j = 0; j < 4; ++j) v[j] = *((const f32x4*)src + lane + 64 * j);
    } else {
        const float* Xrow = lat ? a.out + (size_t)r * D : (const float*)(a.ws + WS_XC) + (size_t)(r - MLAT) * D;
#pragma unroll
        for (int j = 0; j < 4; ++j) v[j] = *((const f32x4*)Xrow + lane + 64 * j);
    }
}
template <int MODE>
__device__ __forceinline__ void ln_finish(const Args& a, int sub, int li, int r, int lane, f32x4 (&v)[4]) {
    const float* mt = (const float*)(a.ws + WS_M);
    const float* tab = (const float*)(a.ws + WS_TAB);
    bf16* H = (bf16*)(a.ws + WS_H);
    const bool lat = r < MLAT; const int b = lat ? (r >> 11) : 32;
    float* Xrow = lat ? a.out + (size_t)r * D : (float*)(a.ws + WS_XC) + (size_t)(r - MLAT) * D;
    if (MODE == 0) {
        if (lat) { const int t = r & 2047; const float* tr = tab + (t >> 6) * 512; const float* tcl = tab + (t & 63) * 512;
            v[0] += *((const f32x4*)tr + lane); v[1] += *((const f32x4*)tr + lane + 64); v[2] += *((const f32x4*)tcl + lane); v[3] += *((const f32x4*)tcl + lane + 64); }
    } else {
        float s = 0.f;
#pragma unroll
        for (int j = 0; j < 4; ++j) s += (v[j].x + v[j].y) + (v[j].z + v[j].w);
        const float mean = wave_sum(s) * (1.f / D); float s2 = 0.f;
#pragma unroll
        for (int j = 0; j < 4; ++j) { v[j] = v[j] - mean; s2 += (v[j].x * v[j].x + v[j].y * v[j].y) + (v[j].z * v[j].z + v[j].w * v[j].w); }
        const float rstd = 1.f / sqrtf(wave_sum(s2) * (1.f / D) + LN_EPS);
        const float* gn = a.ln_gain + li * D; const float* bs = a.ln_bias + li * D;
#pragma unroll
        for (int j = 0; j < 4; ++j) { const f32x4 g4 = *((const f32x4*)gn + lane + 64 * j), b4 = *((const f32x4*)bs + lane + 64 * j); v[j] = v[j] * rstd * g4 + b4; if (MODE == 2) *((f32x4*)Xrow + lane + 64 * j) = v[j]; }
        if (MODE == 1 && lane == 0) { float* st = (float*)(a.ws + WS_STATS) + 2 * (size_t)r; st[0] = mean; st[1] = rstd; }
    }
    if (MODE != 2) {
        float s = 0.f;
#pragma unroll
        for (int j = 0; j < 4; ++j) s += (v[j].x + v[j].y) + (v[j].z + v[j].w);
        const float mean = wave_sum(s) * (1.f / D); float s2 = 0.f;
#pragma unroll
        for (int j = 0; j < 4; ++j) { v[j] = v[j] - mean; s2 += (v[j].x * v[j].x + v[j].y * v[j].y) + (v[j].z * v[j].z + v[j].w * v[j].w); }
        const float rstd = 1.f / sqrtf(wave_sum(s2) * (1.f / D) + LN_EPS);
        const float* m0 = mt + ((size_t)b * 9 + 3 * sub) * D; const float* m1 = m0 + D;
        u32x2* o8 = (u32x2*)(H + (size_t)r * D) + lane;
#pragma unroll
        for (int j = 0; j < 4; ++j) { const f32x4 s4 = *((const f32x4*)m0 + lane + 64 * j), t4 = *((const f32x4*)m1 + lane + 64 * j);
            const f32x4 h = v[j] * rstd * (s4 + 1.0f) + t4; u32x2 w; w.x = pk2(h.x, h.y); w.y = pk2(h.z, h.w); o8[64 * j] = w; }
    }
}
template <int MODE>
__device__ __forceinline__ void ln_pass(const Args& a, int sub, int li, int nrows) {
    const int tid = threadIdx.x, lane = tid & 63, wave = tid >> 6;
    const int gw = blockIdx.x * 8 + wave, NGW = gridDim.x * 8;
    for (int r = gw; r < nrows; r += 2 * NGW) {
        const int r2 = r + NGW; const bool two = r2 < nrows;
        f32x4 va[4], vb[4];
        ln_load<MODE>(a, r, lane, va);
        if (two) ln_load<MODE>(a, r2, lane, vb);
        ln_finish<MODE>(a, sub, li, r, lane, va);
        if (two) ln_finish<MODE>(a, sub, li, r2, lane, vb);
    }
}
__device__ __forceinline__ float silu_q(float g) { return g * __builtin_amdgcn_rcpf(1.0f + __expf(-g)); }

#define BAR_LDS() do { asm volatile("s_waitcnt lgkmcnt(0)" ::: "memory"); __builtin_amdgcn_s_barrier(); asm volatile("" ::: "memory"); } while (0)
#define MFMA32(a_, b_, c_) __builtin_amdgcn_mfma_f32_32x32x16_bf16((a_), (b_), (c_), 0, 0, 0)
typedef float f32x2_t __attribute__((ext_vector_type(2)));
typedef __bf16 bf16x2_t __attribute__((ext_vector_type(2)));
__device__ __forceinline__ unsigned cvtpk(float lo, float hi) { f32x2_t v = {lo, hi}; bf16x2_t b = __builtin_convertvector(v, bf16x2_t); return __builtin_bit_cast(unsigned, b); }
__device__ __forceinline__ bf16x8 pack8(const f32x16& x, int s) {
    u32x4 p; p.x = cvtpk(x[8 * s], x[8 * s + 1]); p.y = cvtpk(x[8 * s + 2], x[8 * s + 3]); p.z = cvtpk(x[8 * s + 4], x[8 * s + 5]); p.w = cvtpk(x[8 * s + 6], x[8 * s + 7]);
    return __builtin_bit_cast(bf16x8, p);
}
__device__ __forceinline__ int scan_base(int s, int dir, int b) {
    if (s < 8) return MLAT + b * TC + 32 * (dir ? 7 - s : s);
    return b * T + 32 * (dir ? 63 - (s - 8) : s - 8);
}
__device__ __forceinline__ const bf16* fptr(const bf16* F, int col, size_t row) { return F + ((size_t)(col >> 7) * FMROWS + row) * 128 + (col & 127); }
template <int DK>
__device__ __forceinline__ void scan_item(const Args& a, LAS unsigned char* lds, const int b, const int head) {
    constexpr bool HGR = (DK == 128);
    constexpr int TPT = DK / 8, NG = 32 / TPT, QS = DK + 8, TS = 40;
    constexpr int VS = 136;
    constexpr int OFF_QD = 0, OFF_KI = OFF_QD + 32 * QS * 2, OFF_KT = OFF_KI + 32 * QS * 2, OFF_VT = OFF_KT + DK * TS * 2, OFF_DEC = OFF_VT + 128 * TS * 2,
                  OFF_CS = OFF_DEC + DK * 4, OFF_SSQ = OFF_CS + NG * DK * 4, OFF_RQ = OFF_SSQ + 512, OFF_RK = OFF_RQ + 32 * QS * 2, OFF_RV = OFF_RK + 32 * QS * 2,
                  OFF_RL = OFF_RV + 32 * VS * 2, OFF_ZL = OFF_RL + 32 * 16 * 2, DIRB = 68608;
    static_assert((HGR ? OFF_ZL : OFF_ZL + 32 * 64 * 4) <= DIRB - 512 && 2 * DIRB <= LDS_BYTES, "scan LDS map");
    const int tid = threadIdx.x, lane = tid & 63, wave = tid >> 6, dir = wave >> 2, dvq = wave & 3, gt = tid & 255;
    const int l31 = lane & 31, h = lane >> 5;
    LAS unsigned char* L = lds + dir * DIRB;
    LAS bf16* QD = (LAS bf16*)(L + OFF_QD); LAS bf16* KI = (LAS bf16*)(L + OFF_KI); LAS bf16* KT = (LAS bf16*)(L + OFF_KT); LAS bf16* VT = (LAS bf16*)(L + OFF_VT);
    LAS float* DEC = (LAS float*)(L + OFF_DEC); LAS float* CS = (LAS float*)(L + OFF_CS); LAS float* SSQ = (LAS float*)(L + OFF_SSQ);
    LAS bf16* RQ = (LAS bf16*)(L + OFF_RQ); LAS bf16* RK = (LAS bf16*)(L + OFF_RK); LAS bf16* RV = (LAS bf16*)(L + OFF_RV); LAS bf16* RL = (LAS bf16*)(L + OFF_RL); LAS float* ZL = (LAS float*)(L + OFF_ZL);
    const bf16* F = (const bf16*)(a.ws + WS_FEAT);
    bf16* OB = (bf16*)(a.ws + WS_OB); bf16* MG = (bf16*)(a.ws + WS_H);
    const int c = gt % DK, tg = gt / DK;
    const int vn = gt & 127, vth = gt >> 7;
    float abias = 0.f;
    const int lrw = dir ? 2 : 0;
    bf16x8 a2b[2];
#pragma unroll
    for (int j = 0; j < 2; ++j) a2b[j] = (bf16x8){0, 0, 0, 0, 0, 0, 0, 0};
    if (!HGR) { const float* a2 = dir ? a.a2_b : a.a2_f;
        if (dvq == lrw) {
#pragma unroll
            for (int j = 0; j < 2; ++j) { const float* ap = a2 + (8 * h) * 256 + head * 64 + 32 * j + l31; u32x4 w;
                w.x = cvtpk(ap[0], ap[256]); w.y = cvtpk(ap[512], ap[768]); w.z = cvtpk(ap[1024], ap[1280]); w.w = cvtpk(ap[1536], ap[1792]); a2b[j] = __builtin_bit_cast(bf16x8, w); } }
        abias = (dir ? a.abias_b : a.abias_f)[head * 64 + c]; }
    const int qcol0 = HGR ? HQ + head * 128 : GQ + head * 64;
    const int kcol0 = HGR ? (dir ? HFB : HFF) + head * 128 : GK + head * 64;
    const int vcol0 = (HGR ? HI : GV) + head * 128;
    const int lrcol = dir ? LRB : LRF;
    const int gcol = (HGR ? HG : GG) + head * 128;
    const int mcol = (HGR ? 512 : 0) + head * 128;
    const float* gain = HGR ? a.hgrn_gain : a.gla_gain;
    const float qscale = HGR ? 0.08838834764831845f : 0.125f;

    LAS float* GN = (LAS float*)(L + DIRB - 512);
    if (gt < 128) GN[gt] = gain[gt];
    f32x16 S[DK / 32];
#pragma unroll
    for (int t = 0; t < DK / 32; ++t)
#pragma unroll
        for (int r = 0; r < 16; ++r) S[t][r] = 0.f;

    constexpr int NVQ = DK / 64, VPR = DK / 8;
    u32x4 Rq[NVQ], Rk[NVQ], Rv[2], Rl = (u32x4){0u, 0u, 0u, 0u};
#define SCAN_LOAD(s_) do { const int base_ = scan_base((s_), dir, b) + ((s_) < 8 ? 1152 : b * 36); \
        _Pragma("unroll") for (int i = 0; i < NVQ; ++i) { const int vid = gt + 256 * i, ti = vid / VPR, cv = vid % VPR; const size_t row = (size_t)(base_ + (dir ? 31 - ti : ti)); \
            Rq[i] = *(const u32x4*)fptr(F, qcol0 + 8 * cv, row); Rk[i] = *(const u32x4*)fptr(F, kcol0 + 8 * cv, row); } \
        _Pragma("unroll") for (int i = 0; i < 2; ++i) { const int vid = gt + 256 * i, ti = vid >> 4, cv = vid & 15; const size_t row = (size_t)(base_ + (dir ? 31 - ti : ti)); \
            Rv[i] = *(const u32x4*)fptr(F, vcol0 + 8 * cv, row); } \
        if (!HGR && dvq == lrw) { const int ti = lane >> 1; const size_t row = (size_t)(base_ + (dir ? 31 - ti : ti)); Rl = *(const u32x4*)fptr(F, lrcol + 8 * (lane & 1), row); } } while (0)
#define SCAN_STORE_RAW() do { \
        _Pragma("unroll") for (int i = 0; i < NVQ; ++i) { const int vid = gt + 256 * i, ti = vid / VPR, cv = vid % VPR; *(LAS u32x4*)(RQ + ti * QS + 8 * cv) = Rq[i]; *(LAS u32x4*)(RK + ti * QS + 8 * cv) = Rk[i]; } \
        _Pragma("unroll") for (int i = 0; i < 2; ++i) { const int vid = gt + 256 * i, ti = vid >> 4, cv = vid & 15; *(LAS u32x4*)(RV + ti * VS + 8 * cv) = Rv[i]; } \
        if (!HGR && dvq == lrw) { *(LAS u32x4*)(RL + (lane >> 1) * 16 + 8 * (lane & 1)) = Rl; \
            asm volatile("s_waitcnt lgkmcnt(0)" ::: "memory"); \
            const bf16x8 la_ = *(const LAS bf16x8*)(RL + l31 * 16 + 8 * h); \
            _Pragma("unroll") for (int j = 0; j < 2; ++j) { f32x16 z_; _Pragma("unroll") for (int r = 0; r < 16; ++r) z_[r] = 0.f; \
                z_ = MFMA32(la_, a2b[j], z_); \
                _Pragma("unroll") for (int r = 0; r < 16; ++r) ZL[((r & 3) + 8 * (r >> 2) + 4 * h) * 64 + 32 * j + l31] = z_[r]; } } } while (0)
    SCAN_LOAD(0);
    SCAN_STORE_RAW();
    __syncthreads();
    for (int s = 0; s < 72; ++s) {
        const bool is_out = s >= 8, second = s >= 40;
        const int base = scan_base(s, dir, b);
        const size_t orow = (size_t)(base + (dir ? 31 - l31 : l31));
        u32x2 pob[4], pgt[4];
#pragma unroll
        for (int g4 = 0; g4 < 4; ++g4) { pob[g4] = (u32x2){0u, 0u}; pgt[g4] = (u32x2){0u, 0u}; }
        if (is_out && second) {
#pragma unroll
            for (int g4 = 0; g4 < 4; ++g4) { const int vc = 32 * dvq + 8 * g4 + 4 * h;
                pob[g4] = *(const u32x2*)(OB + ((size_t)(mcol >> 7) * MLAT + orow) * 128 + vc); pgt[g4] = *(const u32x2*)fptr(F, gcol + vc, orow + b * 36); }
        }
        if (s + 1 < 72) SCAN_LOAD(s + 1);
        float bl[TPT], qv[TPT], kv[TPT]; float run = HGR ? 1.f : 0.f;
#pragma unroll
        for (int i = 0; i < TPT; ++i) {
            const int ti = tg * TPT + i;
            const float q = bf2f(RQ[ti * QS + c]), k = bf2f(RK[ti * QS + c]);
            if (HGR) { run *= (1.0f - k); }
            else { const float z = abias + ZL[ti * 64 + c];
                run += (fminf(z, 0.f) * 1.44269504089f - __builtin_amdgcn_logf(1.0f + __builtin_amdgcn_exp2f(-1.44269504089f * fabsf(z)))) * 0.0625f; }
            bl[i] = run; qv[i] = q; kv[i] = k;
        }
        CS[tg * DK + c] = run;
        { u32x4 w0, w1; unsigned short rv[16];
#pragma unroll
          for (int i = 0; i < 16; ++i) rv[i] = RV[(16 * vth + i) * VS + vn];
          w0.x = rv[0] | ((unsigned)rv[1] << 16); w0.y = rv[2] | ((unsigned)rv[3] << 16); w0.z = rv[4] | ((unsigned)rv[5] << 16); w0.w = rv[6] | ((unsigned)rv[7] << 16);
          w1.x = rv[8] | ((unsigned)rv[9] << 16); w1.y = rv[10] | ((unsigned)rv[11] << 16); w1.z = rv[12] | ((unsigned)rv[13] << 16); w1.w = rv[14] | ((unsigned)rv[15] << 16);
          *(LAS u32x4*)(VT + vn * TS + 16 * vth) = w0; *(LAS u32x4*)(VT + vn * TS + 16 * vth + 8) = w1; }
        BAR_LDS();
        float prefix = HGR ? 1.f : 0.f, btot = HGR ? 1.f : 0.f;
#pragma unroll
        for (int t = 0; t < NG; ++t) { const float v = CS[t * DK + c]; if (HGR) { btot *= v; if (t < tg) prefix *= v; } else { btot += v; if (t < tg) prefix += v; } }
        const float dec = HGR ? btot : __builtin_amdgcn_exp2f(btot);
        unsigned ktp[TPT / 2], wqp[TPT / 2], wkp[TPT / 2];
#pragma unroll
        for (int i = 0; i < TPT; i += 2) {
            const float e0 = HGR ? prefix * bl[i] : __builtin_amdgcn_exp2f(prefix + bl[i]), e1 = HGR ? prefix * bl[i + 1] : __builtin_amdgcn_exp2f(prefix + bl[i + 1]);
            const float ki0 = kv[i] * __builtin_amdgcn_rcpf(e0), ki1 = kv[i + 1] * __builtin_amdgcn_rcpf(e1);
            wqp[i >> 1] = cvtpk(qv[i] * e0, qv[i + 1] * e1); wkp[i >> 1] = cvtpk(ki0, ki1);
            ktp[i >> 1] = cvtpk(ki0 * dec, ki1 * dec);
        }
        if (is_out) {
#pragma unroll
            for (int i = 0; i < TPT; i += 2) { const int ti = tg * TPT + i;
                QD[ti * QS + c] = (bf16)(wqp[i >> 1] & 0xffffu); QD[(ti + 1) * QS + c] = (bf16)(wqp[i >> 1] >> 16);
                KI[ti * QS + c] = (bf16)(wkp[i >> 1] & 0xffffu); KI[(ti + 1) * QS + c] = (bf16)(wkp[i >> 1] >> 16); }
        }
#pragma unroll
        for (int i = 0; i < TPT / 8; ++i) { u32x4 w; w.x = ktp[4 * i]; w.y = ktp[4 * i + 1]; w.z = ktp[4 * i + 2]; w.w = ktp[4 * i + 3]; *(LAS u32x4*)(KT + c * TS + tg * TPT + 8 * i) = w; }
        if (tg == 0) DEC[c] = dec;
        BAR_LDS();
#define SB() __builtin_amdgcn_sched_barrier(0)
        f32x16 OT;
#pragma unroll
        for (int r = 0; r < 16; ++r) OT[r] = 0.f;
        if (is_out) {
            f32x16 accT0;
#pragma unroll
            for (int r = 0; r < 16; ++r) accT0[r] = 0.f;
#pragma unroll
            for (int hb = 0; hb < DK / 64; ++hb) {
                bf16x8 kia[4], qdb[4];
#pragma unroll
                for (int s2 = 0; s2 < 4; ++s2) { kia[s2] = *(const LAS bf16x8*)(KI + l31 * QS + 64 * hb + 16 * s2 + 8 * h); qdb[s2] = *(const LAS bf16x8*)(QD + l31 * QS + 64 * hb + 16 * s2 + 8 * h); }
                SB();
#pragma unroll
                for (int s2 = 0; s2 < 4; ++s2) accT0 = MFMA32(kia[s2], qdb[s2], accT0);
            }
            s16x4 vlo[2], vhi[2];
#pragma unroll
            for (int u = 0; u < 2; ++u) { vlo[u] = *(const LAS s16x4*)(VT + (32 * dvq + l31) * TS + 16 * u + 4 * h); vhi[u] = *(const LAS s16x4*)(VT + (32 * dvq + l31) * TS + 16 * u + 8 + 4 * h); }
#pragma unroll
            for (int tb = 0; tb < DK / 64; ++tb) {
                s16x4 qlo[2][2], qhi[2][2];
#pragma unroll
                for (int t = 0; t < 2; ++t)
#pragma unroll
                    for (int u = 0; u < 2; ++u) { qlo[t][u] = *(const LAS s16x4*)(QD + l31 * QS + 64 * tb + 32 * t + 16 * u + 4 * h); qhi[t][u] = *(const LAS s16x4*)(QD + l31 * QS + 64 * tb + 32 * t + 16 * u + 8 + 4 * h); }
                SB();
#pragma unroll
                for (int t = 0; t < 2; ++t) {
                    const bf16x8 sa0 = pack8(S[2 * tb + t], 0), sa1 = pack8(S[2 * tb + t], 1);
                    OT = MFMA32(sa0, __builtin_shufflevector(qlo[t][0], qhi[t][0], 0, 1, 2, 3, 4, 5, 6, 7), OT);
                    OT = MFMA32(sa1, __builtin_shufflevector(qlo[t][1], qhi[t][1], 0, 1, 2, 3, 4, 5, 6, 7), OT);
                }
            }
#pragma unroll
            for (int r = 0; r < 16; ++r) { const int j = (r & 3) + 8 * (r >> 2) + 4 * h; if (j > l31) accT0[r] = 0.f; }
            OT = MFMA32(__builtin_shufflevector(vlo[0], vhi[0], 0, 1, 2, 3, 4, 5, 6, 7), pack8(accT0, 0), OT);
            OT = MFMA32(__builtin_shufflevector(vlo[1], vhi[1], 0, 1, 2, 3, 4, 5, 6, 7), pack8(accT0, 1), OT);
        }
        {
            bf16x8 vtb[2];
#pragma unroll
            for (int u = 0; u < 2; ++u) vtb[u] = *(const LAS bf16x8*)(VT + (32 * dvq + l31) * TS + 16 * u + 8 * h);
#pragma unroll
            for (int tb = 0; tb < DK / 64; ++tb) {
                bf16x8 kta[2][2];
#pragma unroll
                for (int t = 0; t < 2; ++t)
#pragma unroll
                    for (int u = 0; u < 2; ++u) kta[t][u] = *(const LAS bf16x8*)(KT + (64 * tb + 32 * t + l31) * TS + 16 * u + 8 * h);
#pragma unroll
                for (int t = 0; t < 2; ++t)
#pragma unroll
                    for (int g4 = 0; g4 < 4; ++g4) { const f32x4 d4 = *(const LAS f32x4*)(DEC + 64 * tb + 32 * t + 8 * g4 + 4 * h); const int tt = 2 * tb + t;
                        S[tt][4 * g4] *= d4.x; S[tt][4 * g4 + 1] *= d4.y; S[tt][4 * g4 + 2] *= d4.z; S[tt][4 * g4 + 3] *= d4.w; }
                SB();
#pragma unroll
                for (int u = 0; u < 2; ++u)
#pragma unroll
                    for (int t = 0; t < 2; ++t) S[2 * tb + t] = MFMA32(kta[t][u], vtb[u], S[2 * tb + t]);
            }
        }
#undef SB
        if (is_out) {
            const size_t row = orow;
            if (!second) {
#pragma unroll
                for (int g4 = 0; g4 < 4; ++g4) { u32x2 w; w.x = cvtpk(OT[4 * g4], OT[4 * g4 + 1]); w.y = cvtpk(OT[4 * g4 + 2], OT[4 * g4 + 3]);
                    *(u32x2*)(OB + ((size_t)(mcol >> 7) * MLAT + row) * 128 + 32 * dvq + 8 * g4 + 4 * h) = w; }
            } else {
                float ss = 0.f;
#pragma unroll
                for (int g4 = 0; g4 < 4; ++g4) { const u32x2 w = pob[g4];
                    OT[4 * g4] += __builtin_bit_cast(float, w.x << 16); OT[4 * g4 + 1] += __builtin_bit_cast(float, w.x & 0xffff0000u);
                    OT[4 * g4 + 2] += __builtin_bit_cast(float, w.y << 16); OT[4 * g4 + 3] += __builtin_bit_cast(float, w.y & 0xffff0000u); }
#pragma unroll
                for (int r = 0; r < 16; ++r) ss += OT[r] * OT[r];
                ss += __shfl_xor(ss, 32);
                if (h == 0) SSQ[dvq * 32 + l31] = ss;
                BAR_LDS();
                const float tot = (SSQ[l31] + SSQ[32 + l31]) + (SSQ[64 + l31] + SSQ[96 + l31]);
                const float rs = 1.0f / sqrtf(tot * (1.0f / 128.0f) + NORM_EPS);
#pragma unroll
                for (int g4 = 0; g4 < 4; ++g4) { const int vc = 32 * dvq + 8 * g4 + 4 * h;
                    const u32x2 gw = pgt[g4]; const f32x4 gn = *(const LAS f32x4*)(GN + vc);
                    const float y0 = OT[4 * g4] * rs * gn.x * __builtin_bit_cast(float, gw.x << 16), y1 = OT[4 * g4 + 1] * rs * gn.y * __builtin_bit_cast(float, gw.x & 0xffff0000u);
                    const float y2 = OT[4 * g4 + 2] * rs * gn.z * __builtin_bit_cast(float, gw.y << 16), y3 = OT[4 * g4 + 3] * rs * gn.w * __builtin_bit_cast(float, gw.y & 0xffff0000u);
                    u32x2 w; w.x = cvtpk(y0, y1); w.y = cvtpk(y2, y3);
                    *(u32x2*)(MG + row * D + mcol + vc) = w; }
            }
        }
        if (s + 1 < 72) SCAN_STORE_RAW();
        if (s == 39) __syncthreads(); else BAR_LDS();
    }
#undef SCAN_LOAD
#undef SCAN_STORE_RAW
}

__global__ void __launch_bounds__(512, 2) mega(Args a) {
    extern __shared__ __attribute__((aligned(16))) unsigned char lds_raw[];
    LAS unsigned char* lds = (LAS unsigned char*)lds_raw;
    cg::grid_group grid = cg::this_grid();
    unsigned char* ws = a.ws;
    const int lo = a.ph_lo, hi = a.ph_hi;
#define IN(k) (lo <= (k) && (k) < hi)
#define SEAM(k) do { if (IN(k) && IN((k) + 1)) grid.sync(); } while (0)
    float* xc = (float*)(ws + WS_XC); const float* mt = (const float*)(ws + WS_M);
    pg8::bf16_t* H = (pg8::bf16_t*)(ws + WS_H); pg8::bf16_t* HID = (pg8::bf16_t*)(ws + WS_FEAT); pg8::bf16_t* FEAT = (pg8::bf16_t*)(ws + WS_FEAT);
    const int G = gridDim.x, cu = blockIdx.x;

    if (IN(0)) p0_prologue(a, lds);
    SEAM(0);
    if (IN(1)) ln_pass<0>(a, 0, 0, MALL);
    SEAM(1);
    if (IN(2)) { pg8::Gemm g{H, (const pg8::bf16_t*)(ws + WS_W1IN), MALL, 2 * DFF, D}; pg8::StaticOrder S; S.init(MALL, 2 * DFF, G, cu);
        pg8::EpiSwiGLU E{HID, DFF}; pg8::gemm_phase<pg8::EpiSwiGLU, pg8::StaticOrder, true, true>(lds, g, S, E); }
    SEAM(2);
    if (IN(3)) { pg8::Gemm g{HID, (const pg8::bf16_t*)(ws + WS_W1OUT), MALL, D, DFF}; pg8::StaticOrder S; S.init(MALL, D, G, cu);
        pg8::EpiResid E{a.out, xc, mt, 2, 0.5f, DN_ALPHA, a.x, a.ctx, (const float*)(ws + WS_TAB), nullptr, nullptr, nullptr}; pg8::gemm_phase<pg8::EpiResid, pg8::StaticOrder, true, true>(lds, g, S, E); }
    SEAM(3);
    if (IN(4)) ln_pass<1>(a, 1, 0, MALL);
    SEAM(4);
    if (IN(5)) { pg8::Gemm g{H, (const pg8::bf16_t*)(ws + WS_WMIX), MALL, FW, D}; pg8::StaticOrder S; S.init(MALL, FW, G, cu);
        pg8::EpiFeat E{FEAT, FMROWS, (const float*)(ws + WS_TAB + 256 * 1024)}; pg8::gemm_phase<pg8::EpiFeat, pg8::StaticOrder, true, true>(lds, g, S, E); }
    SEAM(5);
    if (IN(6)) {
        if (cu < 256) { const int item = cu; const int b = item >> 3, grp = (item >> 2) & 1, head = item & 3;
            if (grp) scan_item<128>(a, lds, b, head); else scan_item<64>(a, lds, b, head); }
    }
    SEAM(6);
    if (IN(7)) { pg8::Gemm g{H, (const pg8::bf16_t*)(ws + WS_WMO), MLAT, D, D}; pg8::StaticOrder S; S.init(MLAT, D, G, cu);
        pg8::EpiResid E{a.out, xc, mt, 5, 1.0f, DN_ALPHA, nullptr, nullptr, nullptr, (const float*)(ws + WS_STATS), a.ln_gain, a.ln_bias}; pg8::gemm_phase<pg8::EpiResid, pg8::StaticOrder, true, true>(lds, g, S, E); }
    SEAM(7);
    if (IN(8)) ln_pass<1>(a, 2, 1, MLAT);
    SEAM(8);
    if (IN(9)) { pg8::Gemm g{H, (const pg8::bf16_t*)(ws + WS_W2IN), MLAT, 2 * DFF, D}; pg8::StaticOrder S; S.init(MLAT, 2 * DFF, G, cu);
        pg8::EpiSwiGLU E{HID, DFF}; pg8::gemm_phase<pg8::EpiSwiGLU, pg8::StaticOrder, true, true>(lds, g, S, E); }
    SEAM(9);
    if (IN(10)) { pg8::Gemm g{HID, (const pg8::bf16_t*)(ws + WS_W2OUT), MLAT, D, DFF}; pg8::StaticOrder S; S.init(MLAT, D, G, cu);
        pg8::EpiResid E{a.out, xc, mt, 8, 0.5f, DN_ALPHA, nullptr, nullptr, nullptr, (const float*)(ws + WS_STATS), a.ln_gain + D, a.ln_bias + D}; pg8::gemm_phase<pg8::EpiResid, pg8::StaticOrder, true, true>(lds, g, S, E); }
    SEAM(10);
    if (IN(11)) ln_pass<2>(a, 0, 2, MLAT);
#undef IN
#undef SEAM
}

extern "C" void kernel_launch(void* const* d_in, const int* in_sizes, int n_in, void* d_out, int out_size, void* d_ws, size_t ws_size, hipStream_t stream) {
    static int grid = 0;
    if (grid == 0) {
        if (n_in != 21 || out_size != MLAT * D || ws_size < WS_END) { fprintf(stderr, "kernel_launch: unexpected shapes: n_in %d out %d ws %zu (need %zu)\n", n_in, out_size, ws_size, (size_t)WS_END); grid = -1; return; }
        int dev = 0, cus = 0, per_cu = 0;
        (void)hipGetDevice(&dev); (void)hipDeviceGetAttribute(&cus, hipDeviceAttributeMultiprocessorCount, dev);
        (void)hipFuncSetAttribute((const void*)mega, hipFuncAttributeMaxDynamicSharedMemorySize, LDS_BYTES);
        (void)hipOccupancyMaxActiveBlocksPerMultiprocessor(&per_cu, (const void*)mega, 512, LDS_BYTES);
        (void)hipGetLastError();
        grid = cus > 0 ? cus : 256; if (grid < 256) fprintf(stderr, "kernel_launch: this kernel needs >= 256 CUs (scan phase: one item per workgroup)\n");
        if (per_cu < 1) fprintf(stderr, "kernel_launch: occupancy query reports %d blocks per CU\n", per_cu);
    }
    if (grid < 0) return;
    Args a{};
    const float** p = (const float**)&a;
    for (int i = 0; i < 21; ++i) p[i] = (const float*)d_in[i];
    a.out = (float*)d_out; a.ws = (unsigned char*)d_ws; a.ph_lo = 0; a.ph_hi = 12;
    void* args[] = {&a};
    hipError_t e = hipLaunchCooperativeKernel((void*)mega, dim3(grid), dim3(512), args, LDS_BYTES, stream);
    if (e != hipSuccess) fprintf(stderr, "cooperative launch failed: %s (grid %d)\n", hipGetErrorString(e), grid);
}
```

```cpp
#include <hip/hip_runtime.h>
#include <hip/hip_cooperative_groups.h>
#include <cstdio>
#include <cstdint>
namespace cg = cooperative_groups;
namespace pg8 {
#define PG8_LAS __attribute__((address_space(3)))
typedef unsigned short bf16_t;
typedef short bf16x8 __attribute__((ext_vector_type(8)));
typedef float f32x4 __attribute__((ext_vector_type(4)));
typedef unsigned u32x4 __attribute__((ext_vector_type(4)));
constexpr int BM = 256, BK = 64, HALF = 128, HTB = HALF * BK * 2  , STAGE_BYTES = 8 * HTB, NXCD = 8, WGM = 8;

__host__ __device__ __forceinline__ int lds_byte(int r, int c) { const int st = (r >> 4) * 2 + (c >> 5), rr = r & 15, cc = c & 31, ob = rr * 64 + cc * 2; return st * 1024 + (ob ^ (((ob >> 9) & 1) << 5)); }
__host__ __device__ __forceinline__ void stage_rc(int b, int& R, int& C) { const int st = b / 1024, sb = b % 1024, swz = sb ^ (((sb >> 9) & 1) << 5); R = (st >> 1) * 16 + swz / 64; C = (st & 1) * 32 + (swz % 64) / 2; }
__host__ __device__ __forceinline__ int perm32(int rho) { const int n = rho >> 4, i = rho & 15; return 8 * (i >> 2) + 4 * n + (i & 3); }

struct Unit { int pm, pn; };
struct Gemm { const bf16_t* A; const bf16_t* Bt; int M, N, K; };

struct StaticOrder {
    int nM, nN, nwg, G, c;
    __host__ __device__ void init(int M, int N, int G_, int c_) { nM = M / BM; nN = N / BM; nwg = nM * nN; G = G_; c = c_; }
    __host__ __device__ bool next(int i, Unit& u) const {
        const long L = (long)i * G + c; if (L >= nwg) return false;
        int wgid = (int)L; { const int q = nwg / NXCD, r = nwg % NXCD, xcd = wgid % NXCD, off = wgid / NXCD; wgid = (xcd < r ? xcd * (q + 1) : r * (q + 1) + (xcd - r) * q) + off; }
        const int nig = WGM * nN, gid = wgid / nig, fm = gid * WGM, gsz = (nM - fm) < WGM ? (nM - fm) : WGM;
        u.pm = fm + ((wgid % nig) % gsz); u.pn = (wgid % nig) / gsz; return true;
    }
    __device__ __forceinline__ void a_ready(const Unit&) const {}
    __device__ __forceinline__ void done(const Unit&) const {}
};

struct MixOrder {
    StaticOrder lat; int G, c;
    __host__ __device__ void init(int G_, int c_) { lat.init(65536, 4352, G_, c_); G = G_; c = c_; }
    __host__ __device__ bool next(int i, Unit& u) const {
        const long L = (long)i * G + c; if (L < 4352) return lat.next(i, u);
        const int r = (int)(L - 4352); if (r >= 320) return false;
        const int idx = r % 10; u.pm = 256 + r / 10; u.pn = idx < 3 ? idx + 1 : (idx < 9 ? idx + 5 : 16); return true;
    }
    __device__ __forceinline__ void a_ready(const Unit&) const {}
    __device__ __forceinline__ void done(const Unit&) const {}
};
__device__ __forceinline__ unsigned cvt_pk_bf16(float lo, float hi) { unsigned r; asm volatile("v_cvt_pk_bf16_f32 %0, %1, %2" : "=v"(r) : "v"(lo), "v"(hi)); return r; }
typedef float f32x2 __attribute__((ext_vector_type(2)));
__device__ __forceinline__ float silu_f(float g) { return g * __builtin_amdgcn_rcpf(1.0f + __builtin_amdgcn_exp2f(-1.44269504089f * g)); }
__device__ __forceinline__ unsigned swiglu_pk(f32x2 g, f32x2 u) {
    const f32x2 a = g * (-1.44269504089f); f32x2 e; e.x = __builtin_amdgcn_exp2f(a.x); e.y = __builtin_amdgcn_exp2f(a.y);
    const f32x2 d = e + 1.0f; f32x2 r; r.x = __builtin_amdgcn_rcpf(d.x); r.y = __builtin_amdgcn_rcpf(d.y);
    const f32x2 o = (g * u) * r; return cvt_pk_bf16(o.x, o.y);
}
struct EpiBf16Plain {
    static constexpr bool PERM = true, AFTER_DRAIN = false;
    bf16_t* O; int ldc;
    __device__ __forceinline__ void operator()(const f32x4 (&acc)[2][2][4][2], const Unit& u, int wr, int wc, int fr, int fq) const {
        const int row0 = u.pm * BM + wr * 64 + fr; const int col0 = u.pn * BM + wc * 32 + 8 * fq;
#pragma unroll
        for (int ai = 0; ai < 2; ++ai)
#pragma unroll
            for (int m = 0; m < 4; ++m) { bf16_t* rowp = O + (size_t)(row0 + ai * HALF + m * 16) * ldc + col0;
#pragma unroll
                for (int bj = 0; bj < 2; ++bj) { const f32x4 v0 = acc[ai][bj][m][0], v1 = acc[ai][bj][m][1];
                    u32x4 w; w.x = cvt_pk_bf16(v0[0], v0[1]); w.y = cvt_pk_bf16(v0[2], v0[3]); w.z = cvt_pk_bf16(v1[0], v1[1]); w.w = cvt_pk_bf16(v1[2], v1[3]);
                    *(u32x4*)(rowp + bj * HALF) = w; } }
    }
};
struct EpiBf16Blk {
    static constexpr bool PERM = true, AFTER_DRAIN = false;
    bf16_t* O; int Mrows;
    __device__ __forceinline__ void operator()(const f32x4 (&acc)[2][2][4][2], const Unit& u, int wr, int wc, int fr, int fq) const {
        const int row0 = u.pm * BM + wr * 64 + fr; const int col0 = wc * 32 + 8 * fq;
#pragma unroll
        for (int ai = 0; ai < 2; ++ai)
#pragma unroll
            for (int m = 0; m < 4; ++m) {
#pragma unroll
                for (int bj = 0; bj < 2; ++bj) { const f32x4 v0 = acc[ai][bj][m][0], v1 = acc[ai][bj][m][1];
                    u32x4 w; w.x = cvt_pk_bf16(v0[0], v0[1]); w.y = cvt_pk_bf16(v0[2], v0[3]); w.z = cvt_pk_bf16(v1[0], v1[1]); w.w = cvt_pk_bf16(v1[2], v1[3]);
                    *(u32x4*)(O + ((size_t)(2 * u.pn + bj) * Mrows + (row0 + ai * HALF + m * 16)) * 128 + col0) = w; } }
    }
};
struct EpiFeat {
    static constexpr bool PERM = true, AFTER_DRAIN = false;
    bf16_t* O; int Mrows; const float* oml;
    __device__ __forceinline__ void operator()(const f32x4 (&acc)[2][2][4][2], const Unit& u, int wr, int wc, int fr, int fq) const {
        const int row0 = u.pm * BM + wr * 64 + fr + (u.pm < 256 ? (u.pm >> 3) * 36 : 1152); const int col0 = wc * 32 + 8 * fq; const int pn = u.pn;
        const int mode = pn == 0 ? 1 : ((pn == 6 || pn == 7) ? 2 : ((pn >= 8 && pn <= 11) ? 3 : ((pn == 4 || pn == 5 || pn == 14 || pn == 15) ? 4 : 0)));
        const float* omp = oml + (pn >= 10 ? 512 : 0) + (pn & 1) * 256 + col0;
#pragma unroll
        for (int ai = 0; ai < 2; ++ai)
#pragma unroll
            for (int m = 0; m < 4; ++m) {
#pragma unroll
                for (int bj = 0; bj < 2; ++bj) { f32x4 v0 = acc[ai][bj][m][0], v1 = acc[ai][bj][m][1];
                    if (mode == 1) { v0 = v0 * 0.125f; v1 = v1 * 0.125f; }
                    else if (mode == 2) {
#pragma unroll
                        for (int e = 0; e < 4; ++e) { v0[e] = silu_f(v0[e]) * 0.08838834764831845f; v1[e] = silu_f(v1[e]) * 0.08838834764831845f; } }
                    else if (mode == 4) {
#pragma unroll
                        for (int e = 0; e < 4; ++e) { v0[e] = silu_f(v0[e]); v1[e] = silu_f(v1[e]); } }
                    else if (mode == 3) { const f32x4 o0 = *(const f32x4*)(omp + bj * HALF), o1 = *(const f32x4*)(omp + bj * HALF + 4);
#pragma unroll
                        for (int e = 0; e < 4; ++e) { v0[e] = o0[e] * __builtin_amdgcn_rcpf(1.0f + __builtin_amdgcn_exp2f(1.44269504089f * v0[e]));
                                                      v1[e] = o1[e] * __builtin_amdgcn_rcpf(1.0f + __builtin_amdgcn_exp2f(1.44269504089f * v1[e])); } }
                    u32x4 w; w.x = cvt_pk_bf16(v0[0], v0[1]); w.y = cvt_pk_bf16(v0[2], v0[3]); w.z = cvt_pk_bf16(v1[0], v1[1]); w.w = cvt_pk_bf16(v1[2], v1[3]);
                    *(u32x4*)(O + ((size_t)(2 * pn + bj) * Mrows + (row0 + ai * HALF + m * 16)) * 128 + col0) = w; } }
    }
};
struct EpiSwiGLU {
    static constexpr bool PERM = true, AFTER_DRAIN = false;
    bf16_t* O; int ldc;
    __device__ __forceinline__ void operator()(const f32x4 (&acc)[2][2][4][2], const Unit& u, int wr, int wc, int fr, int fq) const {
        const int row0 = u.pm * BM + wr * 64 + fr; const int col0 = u.pn * HALF + wc * 32 + 8 * fq;
#pragma unroll
        for (int ai = 0; ai < 2; ++ai)
#pragma unroll
            for (int m = 0; m < 4; ++m) { bf16_t* rowp = O + (size_t)(row0 + ai * HALF + m * 16) * ldc + col0;
                const f32x4 g0 = acc[ai][0][m][0], g1 = acc[ai][0][m][1], u0 = acc[ai][1][m][0], u1 = acc[ai][1][m][1];
                u32x4 w;
                w.x = swiglu_pk((f32x2){g0[0], g0[1]}, (f32x2){u0[0], u0[1]}); w.y = swiglu_pk((f32x2){g0[2], g0[3]}, (f32x2){u0[2], u0[3]});
                w.z = swiglu_pk((f32x2){g1[0], g1[1]}, (f32x2){u1[0], u1[1]}); w.w = swiglu_pk((f32x2){g1[2], g1[3]}, (f32x2){u1[2], u1[3]});
                *(u32x4*)rowp = w; }
    }
};
struct EpiResid {
    static constexpr bool PERM = false, AFTER_DRAIN = false;
    float* Xlat; float* Xctx; const float* mtab; int gate_idx; float w; float alpha; const float* srcLat; const float* srcCtx; const float* tab;
    const float* stats; const float* lng; const float* lnb;
    __device__ __forceinline__ void operator()(const f32x4 (&acc)[2][2][4][2], const Unit& u, int wr, int wc, int fr, int fq) const {
        const bool lat = u.pm < 256; const int b = lat ? (u.pm >> 3) : 32;
        const float* g = mtab + ((size_t)b * 9 + gate_idx) * 1024;
        const size_t toff = lat ? (size_t)u.pm * BM * 1024 : (size_t)(u.pm - 256) * BM * 1024;
        float* X = (lat ? Xlat : Xctx) + toff;
        const float* R = srcLat ? (lat ? srcLat : srcCtx) + toff : X;
        const bool addpos = srcLat != nullptr && lat;
        const int col0 = u.pn * BM + wc * 32 + 4 * fq;
#pragma unroll
        for (int bj = 0; bj < 2; ++bj)
#pragma unroll
            for (int n = 0; n < 2; ++n) { const int col = col0 + bj * HALF + n * 16; f32x4 gv = *(const f32x4*)(g + col); gv = gv * w;
                f32x4 lg4 = (f32x4){1.f, 1.f, 1.f, 1.f}, lb4 = (f32x4){0.f, 0.f, 0.f, 0.f};
                if (stats) { lg4 = *(const f32x4*)(lng + col); lb4 = *(const f32x4*)(lnb + col); }
#pragma unroll
                for (int ai = 0; ai < 2; ++ai)
#pragma unroll
                    for (int m = 0; m < 4; ++m) { const int rl = ai * HALF + wr * 64 + m * 16 + fr;
                        f32x4 xv = *(const f32x4*)(R + (size_t)rl * 1024 + col);
                        if (stats) { const f32x2 st = *(const f32x2*)(stats + 2 * ((size_t)u.pm * BM + rl)); xv = (xv - st.x) * st.y * lg4 + lb4; }
                        if (addpos) { const int t = (u.pm * BM + rl) & 2047; xv += *(const f32x4*)(tab + (u.pn < 2 ? (t >> 6) * 512 + col : (t & 63) * 512 + col - 512)); }
                        *(f32x4*)(X + (size_t)rl * 1024 + col) = xv * alpha + gv * acc[ai][bj][m][n]; } }
    }
};
template <class Epi, class Sched, bool ALIGN_EPI = false, bool SP2 = false>
__device__ __forceinline__ void gemm_phase(PG8_LAS unsigned char* lds, const Gemm g, const Sched& S, const Epi& E) {
    const int tid = threadIdx.x, wid = __builtin_amdgcn_readfirstlane(tid >> 6), lane = tid & 63, wr = wid >> 2, wc = wid & 3, fr = lane & 15, fq = lane >> 4;
    const int K = g.K, nt = K / BK;
    unsigned voffA[2], voffB[2];
#pragma unroll
    for (int i = 0; i < 2; ++i) { int R, C; stage_rc(tid * 16 + i * 8192, R, C); const int Rb = Epi::PERM ? ((R & ~31) + perm32(R & 31)) : R;
        voffA[i] = (unsigned)(R * K + C) * 2u; voffB[i] = (unsigned)(Rb * K + C) * 2u; }
    const size_t kstep = (size_t)(BK * 2);
    const size_t hstep = (size_t)HALF * K * 2;
    const size_t tstep = 2 * hstep;
    const unsigned ldsw = (unsigned)wid * 1024u;
    const int aoff = lds_byte(wr * 64 + fr, fq * 8), boff = lds_byte(wc * 32 + fr, fq * 8);
#define PG8_SA(b, h) (((b) * 2 + (h)) * HTB)
#define PG8_SB(b, h) ((4 + (b) * 2 + (h)) * HTB)
#define PG8_STAGE(bufoff, gbase, voff) do { _Pragma("unroll") for (int _i = 0; _i < 2; ++_i) \
        __builtin_amdgcn_global_load_lds((const unsigned*)((const char*)(gbase) + (voff)[_i]), (PG8_LAS unsigned*)(lds + (bufoff) + ldsw + _i * 8192), 16, 0, 0); } while (0)
#define PG8_LDA(dst, b, h) do { _Pragma("unroll") for (int m = 0; m < 4; ++m) _Pragma("unroll") for (int k = 0; k < 2; ++k) dst[m][k] = *(const PG8_LAS bf16x8*)(lds + PG8_SA(b, h) + aoff + m * 2048 + k * 1024); } while (0)
#define PG8_LDB(dst, b, h) do { _Pragma("unroll") for (int n = 0; n < 2; ++n) _Pragma("unroll") for (int k = 0; k < 2; ++k) dst[n][k] = *(const PG8_LAS bf16x8*)(lds + PG8_SB(b, h) + boff + n * 2048 + k * 1024); } while (0)
#define PG8_MMA(ai, bj, At, Bt) do { __builtin_amdgcn_s_setprio(1); _Pragma("unroll") for (int m = 0; m < 4; ++m) _Pragma("unroll") for (int n = 0; n < 2; ++n) _Pragma("unroll") for (int k = 0; k < 2; ++k) \
        acc[ai][bj][m][n] = __builtin_amdgcn_mfma_f32_16x16x32_bf16(Bt[n][k], At[m][k], acc[ai][bj][m][n], 0, 0, 0); __builtin_amdgcn_s_setprio(0); } while (0)
#define PG8_WAIT_V(n) asm volatile("s_waitcnt vmcnt(" #n ")" ::: "memory")
#define PG8_WAIT_L(n) asm volatile("s_waitcnt lgkmcnt(" #n ")" ::: "memory")
#define PG8_BAR __builtin_amdgcn_s_barrier()
#define PG8_SCHED __builtin_amdgcn_sched_barrier(0)
    Unit cur, nxt; int ui = 0;
    if (!S.next(0, cur)) return;
    f32x4 acc[2][2][4][2];
#pragma unroll
    for (int a = 0; a < 2; ++a)
#pragma unroll
        for (int b = 0; b < 2; ++b)
#pragma unroll
            for (int m = 0; m < 4; ++m)
#pragma unroll
                for (int n = 0; n < 2; ++n) acc[a][b][m][n] = (f32x4){0.f, 0.f, 0.f, 0.f};
    bf16x8 At[4][2], B0[2][2], B1[2][2];
    const char* cA = (const char*)g.A + (size_t)cur.pm * tstep; const char* cB = (const char*)g.Bt + (size_t)cur.pn * tstep;
    S.a_ready(cur);
    if constexpr (SP2) {
        PG8_STAGE(PG8_SB(0, 0), cB, voffB); PG8_STAGE(PG8_SB(0, 1), cB + hstep, voffB); PG8_STAGE(PG8_SA(0, 0), cA, voffA); PG8_STAGE(PG8_SA(0, 1), cA + hstep, voffA);
        if (wr == 1) PG8_BAR;
        PG8_WAIT_V(2); PG8_BAR;
        PG8_STAGE(PG8_SB(1, 0), cB + kstep, voffB); PG8_STAGE(PG8_SA(1, 0), cA + kstep, voffA); PG8_STAGE(PG8_SB(1, 1), cB + hstep + kstep, voffB);
        PG8_WAIT_V(6); PG8_BAR;
    } else {
        PG8_STAGE(PG8_SB(0, 0), cB, voffB); PG8_STAGE(PG8_SA(0, 0), cA, voffA); PG8_STAGE(PG8_SB(0, 1), cB + hstep, voffB); PG8_STAGE(PG8_SA(0, 1), cA + hstep, voffA);
        if (wr == 1) PG8_BAR;
        PG8_WAIT_V(4); PG8_BAR;
        PG8_STAGE(PG8_SB(1, 0), cB + kstep, voffB); PG8_STAGE(PG8_SA(1, 0), cA + kstep, voffA); PG8_STAGE(PG8_SB(1, 1), cB + hstep + kstep, voffB);
        PG8_WAIT_V(6); PG8_BAR;
    }
    for (;;) {
        const bool has_next = S.next(ui + 1, nxt);
        const char* nA = has_next ? (const char*)g.A + (size_t)nxt.pm * tstep : cA; const char* nB = has_next ? (const char*)g.Bt + (size_t)nxt.pn * tstep : cB;
        for (int t = 0; t < nt; t += 2) {
            const bool last = (t == nt - 2);
            const char* a1 = cA + (size_t)(t + 1) * kstep;
            const char* a2 = last ? nA : cA + (size_t)(t + 2) * kstep; const char* b2 = last ? nB : cB + (size_t)(t + 2) * kstep;
            const char* a3 = a2 + kstep; const char* b3 = b2 + kstep;
            if (last && has_next) S.a_ready(nxt);
            if constexpr (SP2) {
            PG8_LDB(B0, 0, 0); PG8_LDB(B1, 0, 1); PG8_SCHED; PG8_LDA(At, 0, 0); PG8_STAGE(PG8_SA(1, 1), a1 + hstep, voffA);
            PG8_WAIT_V(8); PG8_WAIT_L(0); PG8_BAR; PG8_MMA(0, 0, At, B0); PG8_MMA(0, 1, At, B1); PG8_BAR; PG8_SCHED;
            PG8_LDA(At, 0, 1); PG8_STAGE(PG8_SB(0, 0), b2, voffB); PG8_STAGE(PG8_SB(0, 1), b2 + hstep, voffB); PG8_STAGE(PG8_SA(0, 0), a2, voffA);
            PG8_WAIT_V(8); PG8_WAIT_L(0); PG8_BAR; PG8_MMA(1, 0, At, B0); PG8_MMA(1, 1, At, B1); PG8_BAR; PG8_SCHED;
            PG8_LDB(B0, 1, 0); PG8_LDB(B1, 1, 1); PG8_SCHED; PG8_LDA(At, 1, 0); PG8_STAGE(PG8_SA(0, 1), a2 + hstep, voffA);
            PG8_WAIT_V(8); PG8_WAIT_L(0); PG8_BAR; PG8_MMA(0, 0, At, B0); PG8_MMA(0, 1, At, B1); PG8_BAR; PG8_SCHED;
            PG8_LDA(At, 1, 1); PG8_STAGE(PG8_SB(1, 0), b3, voffB); PG8_STAGE(PG8_SB(1, 1), b3 + hstep, voffB); PG8_STAGE(PG8_SA(1, 0), a3, voffA);
            PG8_WAIT_V(8); PG8_WAIT_L(0); PG8_BAR; PG8_MMA(1, 0, At, B0); PG8_MMA(1, 1, At, B1); PG8_BAR; PG8_SCHED;
            } else {
            PG8_LDB(B0, 0, 0); PG8_SCHED; PG8_LDA(At, 0, 0); PG8_STAGE(PG8_SA(1, 1), a1 + hstep, voffA);
            PG8_WAIT_L(8); PG8_BAR; PG8_WAIT_L(0); PG8_MMA(0, 0, At, B0); PG8_BAR; PG8_SCHED;
            PG8_LDB(B1, 0, 1); PG8_STAGE(PG8_SB(0, 0), b2, voffB);
            PG8_BAR; PG8_WAIT_L(0); PG8_MMA(0, 1, At, B1); PG8_BAR;
            PG8_LDA(At, 0, 1); PG8_STAGE(PG8_SA(0, 0), a2, voffA);
            PG8_BAR; PG8_WAIT_L(0); PG8_MMA(1, 0, At, B0); PG8_BAR; PG8_SCHED;
            PG8_STAGE(PG8_SB(0, 1), b2 + hstep, voffB);
            PG8_WAIT_V(6); PG8_BAR; PG8_MMA(1, 1, At, B1); PG8_BAR;
            PG8_LDB(B0, 1, 0); PG8_SCHED; PG8_LDA(At, 1, 0); PG8_STAGE(PG8_SA(0, 1), a2 + hstep, voffA);
            PG8_WAIT_L(8); PG8_BAR; PG8_WAIT_L(0); PG8_MMA(0, 0, At, B0); PG8_BAR; PG8_SCHED;
            PG8_LDB(B1, 1, 1); PG8_STAGE(PG8_SB(1, 0), b3, voffB);
            PG8_BAR; PG8_WAIT_L(0); PG8_MMA(0, 1, At, B1); PG8_BAR;
            PG8_LDA(At, 1, 1); PG8_STAGE(PG8_SA(1, 0), a3, voffA);
            PG8_BAR; PG8_WAIT_L(0); PG8_MMA(1, 0, At, B0); PG8_BAR; PG8_SCHED;
            PG8_STAGE(PG8_SB(1, 1), b3 + hstep, voffB);
            PG8_WAIT_V(6); PG8_BAR; PG8_MMA(1, 1, At, B1); PG8_BAR;
            }
        }
        if constexpr (ALIGN_EPI) { if (wr == 0) PG8_BAR; }
        if constexpr (!Epi::AFTER_DRAIN) { E(acc, cur, wr, wc, fr, fq); S.done(cur); }
        if (!has_next) break;
#pragma unroll
        for (int a = 0; a < 2; ++a)
#pragma unroll
            for (int b = 0; b < 2; ++b)
#pragma unroll
                for (int m = 0; m < 4; ++m)
#pragma unroll
                    for (int n = 0; n < 2; ++n) acc[a][b][m][n] = (f32x4){0.f, 0.f, 0.f, 0.f};
        cur = nxt; cA = nA; cB = nB; ++ui;
        if constexpr (ALIGN_EPI) { if (wr == 1) PG8_BAR; }
    }
    PG8_WAIT_V(0);
    if constexpr (!ALIGN_EPI) { if (wr == 0) PG8_BAR; }
    PG8_BAR;
    if constexpr (Epi::AFTER_DRAIN) { E.fused(acc, cur, wr, wc, fr, fq, lds, wid, lane); S.done(cur); }
#undef PG8_SA
#undef PG8_SB
#undef PG8_STAGE
#undef PG8_LDA
#undef PG8_LDB
#undef PG8_MMA
#undef PG8_WAIT_V
#undef PG8_WAIT_L
#undef PG8_BAR
#undef PG8_SCHED
}
}

#define LAS __attribute__((address_space(3)))
typedef unsigned short bf16;
typedef float f32x4 __attribute__((ext_vector_type(4)));
typedef float f32x16 __attribute__((ext_vector_type(16)));
typedef short bf16x8 __attribute__((ext_vector_type(8)));
typedef short s16x4 __attribute__((ext_vector_type(4)));
typedef unsigned u32x4 __attribute__((ext_vector_type(4)));
typedef unsigned u32x2 __attribute__((ext_vector_type(2)));

constexpr int D = 1024, NB = 32, T = 2048, TC = 256, DFF = 2816;
constexpr int MLAT = NB * T, MCTX = NB * TC, MALL = MLAT + MCTX;
constexpr int FMROWS = 75008;
constexpr int FW = 4352;
constexpr int GQ = 0, GK = 256, GV = 512, GG = 1024, HQ = 1536, HFF = 2048, HFB = 2560, HI = 3072, HG = 3584, LRF = 4096, LRB = 4112;
constexpr float LN_EPS = 1e-5f, NORM_EPS = 1e-6f;
constexpr float DN_ALPHA = 1.189207115002721f;
constexpr size_t MiB = 1u << 20;
constexpr size_t WS_M = 0, WS_TAB = 2 * MiB, WS_W1IN = 3 * MiB, WS_W1OUT = 14 * MiB, WS_WMIX = 20 * MiB, WS_WMO = 29 * MiB, WS_W2IN = 31 * MiB, WS_W2OUT = 42 * MiB,
                 WS_XC = 48 * MiB, WS_H = 80 * MiB, WS_OB = 224 * MiB, WS_FEAT = 352 * MiB, WS_END = 976 * MiB;
constexpr size_t WS_STATS = WS_TAB + 384 * 1024;
constexpr int LDS_BYTES = 147456;

struct Args {
    const float *x, *c, *ctx, *c_ctx, *w_ada, *b_ada, *ln_gain, *ln_bias, *ffn1_w_in, *ffn1_w_out, *w_mix_in, *a2_f, *a2_b, *abias_f, *abias_b, *lb_logits,
                *gla_gain, *hgrn_gain, *w_mix_out, *ffn2_w_in, *ffn2_w_out;
    float* out; unsigned char* ws; int ph_lo, ph_hi;
};

__device__ __forceinline__ unsigned f2bf(float f) { unsigned u = __builtin_bit_cast(unsigned, f); return (u + 0x7fffu + ((u >> 16) & 1u)) >> 16; }
__device__ __forceinline__ unsigned pk2(float lo, float hi) { return f2bf(lo) | (f2bf(hi) << 16); }
__device__ __forceinline__ float bf2f(unsigned short v) { return __builtin_bit_cast(float, (unsigned)v << 16); }
__device__ __forceinline__ float wave_sum(float v) {
#pragma unroll
    for (int o = 1; o < 64; o <<= 1) v += __shfl_xor(v, o);
    return v;
}
#define LDS_WAIT() asm volatile("s_waitcnt lgkmcnt(0)" ::: "memory")

__device__ __forceinline__ int remap_row(int kind, int n) {
    if (kind == 1) { const int half = n >= DFF ? 1 : 0, j = n - half * DFF; return 256 * (j >> 7) + 128 * half + (j & 127); }
    if (kind == 2) { return n < 1536 ? n : (n < 1568 ? 4096 + (n - 1536) : n - 32); }
    return n;
}
__device__ __forceinline__ void p0_transpose_item(const float* W, int K, int N, bf16* WT, int kind, LAS float* scr, int item, int lane) {
    const int nblk = N / 32, kb = item / nblk, nb = item % nblk, k0 = 64 * kb, n0 = 32 * nb;
    const int r0 = remap_row(kind, n0);
#pragma unroll 8
    for (int i = 0; i < 32; ++i) { const int kk = 2 * i + (lane >> 5); scr[kk * 33 + (lane & 31)] = W[(size_t)(k0 + kk) * N + n0 + (lane & 31)]; }
    LDS_WAIT(); asm volatile("" ::: "memory");
    const int c = lane & 7;
#pragma unroll
    for (int j = 0; j < 4; ++j) { const int n = (lane >> 3) + 8 * j; const LAS float* s = scr + (8 * c) * 33 + n;
        u32x4 o; o.x = pk2(s[0 * 33], s[1 * 33]); o.y = pk2(s[2 * 33], s[3 * 33]); o.z = pk2(s[4 * 33], s[5 * 33]); o.w = pk2(s[6 * 33], s[7 * 33]);
        *(u32x4*)(WT + (size_t)(r0 + n) * K + k0 + 8 * c) = o; }
    LDS_WAIT(); asm volatile("" ::: "memory");
}
__device__ __forceinline__ void p0_prologue(const Args& a, LAS unsigned char* lds) {
    const int tid = threadIdx.x, lane = tid & 63, wave = tid >> 6;
    const int G = gridDim.x, gw = blockIdx.x * 8 + wave, NGW = G * 8;
    unsigned char* ws = a.ws;
    {
        LAS float* scr = (LAS float*)(lds + wave * 16384);
        constexpr int I_IN = (D / 64) * (2 * DFF / 32), I_OUT = (DFF / 64) * (D / 32), I_MIX = (D / 64) * (4128 / 32), I_MO = (D / 64) * (D / 32);
        constexpr int NITEMS = 2 * I_IN + 2 * I_OUT + I_MIX + I_MO;
        for (int it = gw; it < NITEMS; it += NGW) {
            int r = it;
            if (r < I_IN) { p0_transpose_item(a.ffn1_w_in, D, 2 * DFF, (bf16*)(ws + WS_W1IN), 1, scr, r, lane); continue; } r -= I_IN;
            if (r < I_IN) { p0_transpose_item(a.ffn2_w_in, D, 2 * DFF, (bf16*)(ws + WS_W2IN), 1, scr, r, lane); continue; } r -= I_IN;
            if (r < I_OUT) { p0_transpose_item(a.ffn1_w_out, DFF, D, (bf16*)(ws + WS_W1OUT), 0, scr, r, lane); continue; } r -= I_OUT;
            if (r < I_OUT) { p0_transpose_item(a.ffn2_w_out, DFF, D, (bf16*)(ws + WS_W2OUT), 0, scr, r, lane); continue; } r -= I_OUT;
            if (r < I_MIX) { p0_transpose_item(a.w_mix_in, D, 4128, (bf16*)(ws + WS_WMIX), 2, scr, r, lane); continue; } r -= I_MIX;
            p0_transpose_item(a.w_mix_out, D, D, (bf16*)(ws + WS_WMO), 0, scr, r, lane);
        }
        u32x4* z = (u32x4*)((bf16*)(ws + WS_WMIX) + (size_t)4128 * D);
        for (int i = blockIdx.x * 512 + tid; i < 224 * D / 8; i += G * 512) z[i] = (u32x4){0u, 0u, 0u, 0u};
        float* tab = (float*)(ws + WS_TAB);
        for (int i = blockIdx.x * 512 + tid; i < 64 * 256; i += G * 512) { const int p = i >> 8, q = i & 255;
            const float omega = 1.0f / powf(10000.0f, (float)q * (1.0f / 256.0f)); const float ang = (float)p * omega;
            tab[p * 512 + q] = sinf(ang); tab[p * 512 + 256 + q] = cosf(ang); }
    }
    {
        float* oml = (float*)(ws + WS_TAB + 256 * 1024);
        for (int i = blockIdx.x * 512 + tid; i < 1024; i += G * 512) { const int dr = i >> 9, k = i & 511; const float l0 = a.lb_logits[dr * 1024 + k], l1 = a.lb_logits[dr * 1024 + 512 + k];
            oml[i] = 1.0f - 1.0f / (1.0f + expf(l1 - l0)); }
    }
    __syncthreads();
    for (int item = blockIdx.x; item < 9216 / 64; item += G) {
        LAS float* sc = (LAS float*)lds;
        for (int i = tid; i < 33 * 1024; i += 512) { const float v = i < 32 * 1024 ? a.c[i] : a.c_ctx[i - 32 * 1024]; sc[i] = v / (1.0f + __expf(-v)); }
        __syncthreads();
        float acc[33];
#pragma unroll
        for (int b = 0; b < 33; ++b) acc[b] = 0.f;
        const int n = item * 64 + lane;
        for (int k = wave * 128; k < wave * 128 + 128; ++k) { const float wv = a.w_ada[(size_t)k * 9216 + n];
#pragma unroll
            for (int b = 0; b < 33; ++b) acc[b] += sc[b * 1024 + k] * wv; }
        __syncthreads();
        LAS float* red = (LAS float*)lds;
#pragma unroll
        for (int b = 0; b < 33; ++b) red[(wave * 33 + b) * 64 + lane] = acc[b];
        __syncthreads();
        float* mt = (float*)(ws + WS_M);
        for (int i = tid; i < 33 * 64; i += 512) { const int b = i >> 6, l = i & 63; float s = 0.f;
#pragma unroll
            for (int w = 0; w < 8; ++w) s += red[(w * 33 + b) * 64 + l];
            mt[(size_t)b * 9216 + item * 64 + l] = s + a.b_ada[item * 64 + l]; }
        __syncthreads();
    }
}

template <int MODE>
__device__ __forceinline__ void ln_load(const Args& a, int r, int lane, f32x4 (&v)[4]) {
    const bool lat = r < MLAT;
    if (MODE == 0) {
        const float* src = lat ? a.x + (size_t)r * D : a.ctx + (size_t)(r - MLAT) * D;
#pragma unroll
        for (int j = 0; j < 4; ++j) v[j] = *((const f32x4*)src + lane + 64 * j);
    } else {
        const float* Xrow = lat ? a.out + (size_t)r * D : (const float*)(a.ws + WS_XC) + (size_t)(r - MLAT) * D;
#pragma unroll
        for (int j = 0; j < 4; ++j) v[j] = *((const f32x4*)Xrow + lane + 64 * j);
    }
}
template <int MODE>
__device__ __forceinline__ void ln_finish(const Args& a, int sub, int li, int r, int lane, f32x4 (&v)[4]) {
    const float* mt = (const float*)(a.ws + WS_M);
    const float* tab = (const float*)(a.ws + WS_TAB);
    bf16* H = (bf16*)(a.ws + WS_H);
    const bool lat = r < MLAT; const int b = lat ? (r >> 11) : 32;
    float* Xrow = lat ? a.out + (size_t)r * D : (float*)(a.ws + WS_XC) + (size_t)(r - MLAT) * D;
    if (MODE == 0) {
        if (lat) { const int t = r & 2047; const float* tr = tab + (t >> 6) * 512; const float* tcl = tab + (t & 63) * 512;
            v[0] += *((const f32x4*)tr + lane); v[1] += *((const f32x4*)tr + lane + 64); v[2] += *((const f32x4*)tcl + lane); v[3] += *((const f32x4*)tcl + lane + 64); }
    } else {
        float s = 0.f;
#pragma unroll
        for (int j = 0; j < 4; ++j) s += (v[j].x + v[j].y) + (v[j].z + v[j].w);
        const float mean = wave_sum(s) * (1.f / D); float s2 = 0.f;
#pragma unroll
        for (int j = 0; j < 4; ++j) { v[j] = v[j] - mean; s2 += (v[j].x * v[j].x + v[j].y * v[j].y) + (v[j].z * v[j].z + v[j].w * v[j].w); }
        const float rstd = 1.f / sqrtf(wave_sum(s2) * (1.f / D) + LN_EPS);
        const float* gn = a.ln_gain + li * D; const float* bs = a.ln_bias + li * D;
#pragma unroll
        for (int j = 0; j < 4; ++j) { const f32x4 g4 = *((const f32x4*)gn + lane + 64 * j), b4 = *((const f32x4*)bs + lane + 64 * j); v[j] = v[j] * rstd * g4 + b4; if (MODE == 2) *((f32x4*)Xrow + lane + 64 * j) = v[j]; }
        if (MODE == 1 && lane == 0) { float* st = (float*)(a.ws + WS_STATS) + 2 * (size_t)r; st[0] = mean; st[1] = rstd; }
    }
    if (MODE != 2) {
        float s = 0.f;
#pragma unroll
        for (int j = 0; j < 4; ++j) s += (v[j].x + v[j].y) + (v[j].z + v[j].w);
        const float mean = wave_sum(s) * (1.f / D); float s2 = 0.f;
#pragma unroll
        for (int j = 0; j < 4; ++j) { v[j] = v[j] - mean; s2 += (v[j].x * v[j].x + v[j].y * v[j].y) + (v[j].z * v[j].z + v[j].w * v[j].w); }
        const float rstd = 1.f / sqrtf(wave_sum(s2) * (1.f / D) + LN_EPS);
        const float* m0 = mt + ((size_t)b * 9 + 3 * sub) * D; const float* m1 = m0 + D;
        u32x2* o8 = (u32x2*)(H + (size_t)r * D) + lane;
#pragma unroll
        for (int j = 0; j < 4; ++j) { const f32x4 s4 = *((const f32x4*)m0 + lane + 64 * j), t4 = *((const f32x4*)m1 + lane + 64 * j);
            const f32x4 h = v[j] * rstd * (s4 + 1.0f) + t4; u32x2 w; w.x = pk2(h.x, h.y); w.y = pk2(h.z, h.w); o8[64 * j] = w; }
    }
}
template <int MODE>
__device__ __forceinline__ void ln_pass(const Args& a, int sub, int li, int nrows) {
    const int tid = threadIdx.x, lane = tid & 63, wave = tid >> 6;
    const int gw = blockIdx.x * 8 + wave, NGW = gridDim.x * 8;
    for (int r = gw; r < nrows; r += 2 * NGW) {
        const int r2 = r + NGW; const bool two = r2 < nrows;
        f32x4 va[4], vb[4];
        ln_load<MODE>(a, r, lane, va);
        if (two) ln_load<MODE>(a, r2, lane, vb);
        ln_finish<MODE>(a, sub, li, r, lane, va);
        if (two) ln_finish<MODE>(a, sub, li, r2, lane, vb);
    }
}
__device__ __forceinline__ float silu_q(float g) { return g * __builtin_amdgcn_rcpf(1.0f + __expf(-g)); }

#define BAR_LDS() do { asm volatile("s_waitcnt lgkmcnt(0)" ::: "memory"); __builtin_amdgcn_s_barrier(); asm volatile("" ::: "memory"); } while (0)
#define MFMA32(a_, b_, c_) __builtin_amdgcn_mfma_f32_32x32x16_bf16((a_), (b_), (c_), 0, 0, 0)
typedef float f32x2_t __attribute__((ext_vector_type(2)));
typedef __bf16 bf16x2_t __attribute__((ext_vector_type(2)));
__device__ __forceinline__ unsigned cvtpk(float lo, float hi) { f32x2_t v = {lo, hi}; bf16x2_t b = __builtin_convertvector(v, bf16x2_t); return __builtin_bit_cast(unsigned, b); }
__device__ __forceinline__ bf16x8 pack8(const f32x16& x, int s) {
    u32x4 p; p.x = cvtpk(x[8 * s], x[8 * s + 1]); p.y = cvtpk(x[8 * s + 2], x[8 * s + 3]); p.z = cvtpk(x[8 * s + 4], x[8 * s + 5]); p.w = cvtpk(x[8 * s + 6], x[8 * s + 7]);
    return __builtin_bit_cast(bf16x8, p);
}
__device__ __forceinline__ int scan_base(int s, int dir, int b) {
    if (s < 8) return MLAT + b * TC + 32 * (dir ? 7 - s : s);
    return b * T + 32 * (dir ? 63 - (s - 8) : s - 8);
}
__device__ __forceinline__ const bf16* fptr(const bf16* F, int col, size_t row) { return F + ((size_t)(col >> 7) * FMROWS + row) * 128 + (col & 127); }
template <int DK>
__device__ __forceinline__ void scan_item(const Args& a, LAS unsigned char* lds, const int b, const int head) {
    constexpr bool HGR = (DK == 128);
    constexpr int TPT = DK / 8, NG = 32 / TPT, QS = DK + 8, TS = 40;
    constexpr int VS = 136;
    constexpr int OFF_QD = 0, OFF_KI = OFF_QD + 32 * QS * 2, OFF_KT = OFF_KI + 32 * QS * 2, OFF_VT = OFF_KT + DK * TS * 2, OFF_DEC = OFF_VT + 128 * TS * 2,
                  OFF_CS = OFF_DEC + DK * 4, OFF_SSQ = OFF_CS + NG * DK * 4, OFF_RQ = OFF_SSQ + 512, OFF_RK = OFF_RQ + 32 * QS * 2, OFF_RV = OFF_RK + 32 * QS * 2,
                  OFF_RL = OFF_RV + 32 * VS * 2, OFF_ZL = OFF_RL + 32 * 16 * 2, DIRB = 68608;
    static_assert((HGR ? OFF_ZL : OFF_ZL + 32 * 64 * 4) <= DIRB - 512 && 2 * DIRB <= LDS_BYTES, "scan LDS map");
    const int tid = threadIdx.x, lane = tid & 63, wave = tid >> 6, dir = wave >> 2, dvq = wave & 3, gt = tid & 255;
    const int l31 = lane & 31, h = lane >> 5;
    LAS unsigned char* L = lds + dir * DIRB;
    LAS bf16* QD = (LAS bf16*)(L + OFF_QD); LAS bf16* KI = (LAS bf16*)(L + OFF_KI); LAS bf16* KT = (LAS bf16*)(L + OFF_KT); LAS bf16* VT = (LAS bf16*)(L + OFF_VT);
    LAS float* DEC = (LAS float*)(L + OFF_DEC); LAS float* CS = (LAS float*)(L + OFF_CS); LAS float* SSQ = (LAS float*)(L + OFF_SSQ);
    LAS bf16* RQ = (LAS bf16*)(L + OFF_RQ); LAS bf16* RK = (LAS bf16*)(L + OFF_RK); LAS bf16* RV = (LAS bf16*)(L + OFF_RV); LAS bf16* RL = (LAS bf16*)(L + OFF_RL); LAS float* ZL = (LAS float*)(L + OFF_ZL);
    const bf16* F = (const bf16*)(a.ws + WS_FEAT);
    bf16* OB = (bf16*)(a.ws + WS_OB); bf16* MG = (bf16*)(a.ws + WS_H);
    const int c = gt % DK, tg = gt / DK;
    const int vn = gt & 127, vth = gt >> 7;
    float abias = 0.f;
    const int lrw = dir ? 2 : 0;
    bf16x8 a2b[2];
#pragma unroll
    for (int j = 0; j < 2; ++j) a2b[j] = (bf16x8){0, 0, 0, 0, 0, 0, 0, 0};
    if (!HGR) { const float* a2 = dir ? a.a2_b : a.a2_f;
        if (dvq == lrw) {
#pragma unroll
            for (int j = 0; j < 2; ++j) { const float* ap = a2 + (8 * h) * 256 + head * 64 + 32 * j + l31; u32x4 w;
                w.x = cvtpk(ap[0], ap[256]); w.y = cvtpk(ap[512], ap[768]); w.z = cvtpk(ap[1024], ap[1280]); w.w = cvtpk(ap[1536], ap[1792]); a2b[j] = __builtin_bit_cast(bf16x8, w); } }
        abias = (dir ? a.abias_b : a.abias_f)[head * 64 + c]; }
    const int qcol0 = HGR ? HQ + head * 128 : GQ + head * 64;
    const int kcol0 = HGR ? (dir ? HFB : HFF) + head * 128 : GK + head * 64;
    const int vcol0 = (HGR ? HI : GV) + head * 128;
    const int lrcol = dir ? LRB : LRF;
    const int gcol = (HGR ? HG : GG) + head * 128;
    const int mcol = (HGR ? 512 : 0) + head * 128;
    const float* gain = HGR ? a.hgrn_gain : a.gla_gain;
    const float qscale = HGR ? 0.08838834764831845f : 0.125f;

    LAS float* GN = (LAS float*)(L + DIRB - 512);
    if (gt < 128) GN[gt] = gain[gt];
    f32x16 S[DK / 32];
#pragma unroll
    for (int t = 0; t < DK / 32; ++t)
#pragma unroll
        for (int r = 0; r < 16; ++r) S[t][r] = 0.f;

    constexpr int NVQ = DK / 64, VPR = DK / 8;
    u32x4 Rq[NVQ], Rk[NVQ], Rv[2], Rl = (u32x4){0u, 0u, 0u, 0u};
#define SCAN_LOAD(s_) do { const int base_ = scan_base((s_), dir, b) + ((s_) < 8 ? 1152 : b * 36); \
        _Pragma("unroll") for (int i = 0; i < NVQ; ++i) { const int vid = gt + 256 * i, ti = vid / VPR, cv = vid % VPR; const size_t row = (size_t)(base_ + (dir ? 31 - ti : ti)); \
            Rq[i] = *(const u32x4*)fptr(F, qcol0 + 8 * cv, row); Rk[i] = *(const u32x4*)fptr(F, kcol0 + 8 * cv, row); } \
        _Pragma("unroll") for (int i = 0; i < 2; ++i) { const int vid = gt + 256 * i, ti = vid >> 4, cv = vid & 15; const size_t row = (size_t)(base_ + (dir ? 31 - ti : ti)); \
            Rv[i] = *(const u32x4*)fptr(F, vcol0 + 8 * cv, row); } \
        if (!HGR && dvq == lrw) { const int ti = lane >> 1; const size_t row = (size_t)(base_ + (dir ? 31 - ti : ti)); Rl = *(const u32x4*)fptr(F, lrcol + 8 * (lane & 1), row); } } while (0)
#define SCAN_STORE_RAW() do { \
        _Pragma("unroll") for (int i = 0; i < NVQ; ++i) { const int vid = gt + 256 * i, ti = vid / VPR, cv = vid % VPR; *(LAS u32x4*)(RQ + ti * QS + 8 * cv) = Rq[i]; *(LAS u32x4*)(RK + ti * QS + 8 * cv) = Rk[i]; } \
        _Pragma("unroll") for (int i = 0; i < 2; ++i) { const int vid = gt + 256 * i, ti = vid >> 4, cv = vid & 15; *(LAS u32x4*)(RV + ti * VS + 8 * cv) = Rv[i]; } \
        if (!HGR && dvq == lrw) { *(LAS u32x4*)(RL + (lane >> 1) * 16 + 8 * (lane & 1)) = Rl; \
            asm volatile("s_waitcnt lgkmcnt(0)" ::: "memory"); \
            const bf16x8 la_ = *(const LAS bf16x8*)(RL + l31 * 16 + 8 * h); \
            _Pragma("unroll") for (int j = 0; j < 2; ++j) { f32x16 z_; _Pragma("unroll") for (int r = 0; r < 16; ++r) z_[r] = 0.f; \
                z_ = MFMA32(la_, a2b[j], z_); \
                _Pragma("unroll") for (int r = 0; r < 16; ++r) ZL[((r & 3) + 8 * (r >> 2) + 4 * h) * 64 + 32 * j + l31] = z_[r]; } } } while (0)
    SCAN_LOAD(0);
    SCAN_STORE_RAW();
    __syncthreads();
    for (int s = 0; s < 72; ++s) {
        const bool is_out = s >= 8, second = s >= 40;
        const int base = scan_base(s, dir, b);
        const size_t orow = (size_t)(base + (dir ? 31 - l31 : l31));
        u32x2 pob[4], pgt[4];
#pragma unroll
        for (int g4 = 0; g4 < 4; ++g4) { pob[g4] = (u32x2){0u, 0u}; pgt[g4] = (u32x2){0u, 0u}; }
        if (is_out && second) {
#pragma unroll
            for (int g4 = 0; g4 < 4; ++g4) { const int vc = 32 * dvq + 8 * g4 + 4 * h;
                pob[g4] = *(const u32x2*)(OB + ((size_t)(mcol >> 7) * MLAT + orow) * 128 + vc); pgt[g4] = *(const u32x2*)fptr(F, gcol + vc, orow + b * 36); }
        }
        if (s + 1 < 72) SCAN_LOAD(s + 1);
        float bl[TPT], qv[TPT], kv[TPT]; float run = HGR ? 1.f : 0.f;
#pragma unroll
        for (int i = 0; i < TPT; ++i) {
            const int ti = tg * TPT + i;
            const float q = bf2f(RQ[ti * QS + c]), k = bf2f(RK[ti * QS + c]);
            if (HGR) { run *= (1.0f - k); }
            else { const float z = abias + ZL[ti * 64 + c];
                run += (fminf(z, 0.f) * 1.44269504089f - __builtin_amdgcn_logf(1.0f + __builtin_amdgcn_exp2f(-1.44269504089f * fabsf(z)))) * 0.0625f; }
            bl[i] = run; qv[i] = q; kv[i] = k;
        }
        CS[tg * DK + c] = run;
        { u32x4 w0, w1; unsigned short rv[16];
#pragma unroll
          for (int i = 0; i < 16; ++i) rv[i] = RV[(16 * vth + i) * VS + vn];
          w0.x = rv[0] | ((unsigned)rv[1] << 16); w0.y = rv[2] | ((unsigned)rv[3] << 16); w0.z = rv[4] | ((unsigned)rv[5] << 16); w0.w = rv[6] | ((unsigned)rv[7] << 16);
          w1.x = rv[8] | ((unsigned)rv[9] << 16); w1.y = rv[10] | ((unsigned)rv[11] << 16); w1.z = rv[12] | ((unsigned)rv[13] << 16); w1.w = rv[14] | ((unsigned)rv[15] << 16);
          *(LAS u32x4*)(VT + vn * TS + 16 * vth) = w0; *(LAS u32x4*)(VT + vn * TS + 16 * vth + 8) = w1; }
        BAR_LDS();
        float prefix = HGR ? 1.f : 0.f, btot = HGR ? 1.f : 0.f;
#pragma unroll
        for (int t = 0; t < NG; ++t) { const float v = CS[t * DK + c]; if (HGR) { btot *= v; if (t < tg) prefix *= v; } else { btot += v; if (t < tg) prefix += v; } }
        const float dec = HGR ? btot : __builtin_amdgcn_exp2f(btot);
        unsigned ktp[TPT / 2], wqp[TPT / 2], wkp[TPT / 2];
#pragma unroll
        for (int i = 0; i < TPT; i += 2) {
            const float e0 = HGR ? prefix * bl[i] : __builtin_amdgcn_exp2f(prefix + bl[i]), e1 = HGR ? prefix * bl[i + 1] : __builtin_amdgcn_exp2f(prefix + bl[i + 1]);
            const float ki0 = kv[i] * __builtin_amdgcn_rcpf(e0), ki1 = kv[i + 1] * __builtin_amdgcn_rcpf(e1);
            wqp[i >> 1] = cvtpk(qv[i] * e0, qv[i + 1] * e1); wkp[i >> 1] = cvtpk(ki0, ki1);
            ktp[i >> 1] = cvtpk(ki0 * dec, ki1 * dec);
        }
        if (is_out) {
#pragma unroll
            for (int i = 0; i < TPT; i += 2) { const int ti = tg * TPT + i;
                QD[ti * QS + c] = (bf16)(wqp[i >> 1] & 0xffffu); QD[(ti + 1) * QS + c] = (bf16)(wqp[i >> 1] >> 16);
                KI[ti * QS + c] = (bf16)(wkp[i >> 1] & 0xffffu); KI[(ti + 1) * QS + c] = (bf16)(wkp[i >> 1] >> 16); }
        }
#pragma unroll
        for (int i = 0; i < TPT / 8; ++i) { u32x4 w; w.x = ktp[4 * i]; w.y = ktp[4 * i + 1]; w.z = ktp[4 * i + 2]; w.w = ktp[4 * i + 3]; *(LAS u32x4*)(KT + c * TS + tg * TPT + 8 * i) = w; }
        if (tg == 0) DEC[c] = dec;
        BAR_LDS();
#define SB() __builtin_amdgcn_sched_barrier(0)
        f32x16 OT;
#pragma unroll
        for (int r = 0; r < 16; ++r) OT[r] = 0.f;
        if (is_out) {
            f32x16 accT0;
#pragma unroll
            for (int r = 0; r < 16; ++r) accT0[r] = 0.f;
#pragma unroll
            for (int hb = 0; hb < DK / 64; ++hb) {
                bf16x8 kia[4], qdb[4];
#pragma unroll
                for (int s2 = 0; s2 < 4; ++s2) { kia[s2] = *(const LAS bf16x8*)(KI + l31 * QS + 64 * hb + 16 * s2 + 8 * h); qdb[s2] = *(const LAS bf16x8*)(QD + l31 * QS + 64 * hb + 16 * s2 + 8 * h); }
                SB();
#pragma unroll
                for (int s2 = 0; s2 < 4; ++s2) accT0 = MFMA32(kia[s2], qdb[s2], accT0);
            }
            s16x4 vlo[2], vhi[2];
#pragma unroll
            for (int u = 0; u < 2; ++u) { vlo[u] = *(const LAS s16x4*)(VT + (32 * dvq + l31) * TS + 16 * u + 4 * h); vhi[u] = *(const LAS s16x4*)(VT + (32 * dvq + l31) * TS + 16 * u + 8 + 4 * h); }
#pragma unroll
            for (int tb = 0; tb < DK / 64; ++tb) {
                s16x4 qlo[2][2], qhi[2][2];
#pragma unroll
                for (int t = 0; t < 2; ++t)
#pragma unroll
                    for (int u = 0; u < 2; ++u) { qlo[t][u] = *(const LAS s16x4*)(QD + l31 * QS + 64 * tb + 32 * t + 16 * u + 4 * h); qhi[t][u] = *(const LAS s16x4*)(QD + l31 * QS + 64 * tb + 32 * t + 16 * u + 8 + 4 * h); }
                SB();
#pragma unroll
                for (int t = 0; t < 2; ++t) {
                    const bf16x8 sa0 = pack8(S[2 * tb + t], 0), sa1 = pack8(S[2 * tb + t], 1);
                    OT = MFMA32(sa0, __builtin_shufflevector(qlo[t][0], qhi[t][0], 0, 1, 2, 3, 4, 5, 6, 7), OT);
                    OT = MFMA32(sa1, __builtin_shufflevector(qlo[t][1], qhi[t][1], 0, 1, 2, 3, 4, 5, 6, 7), OT);
                }
            }
#pragma unroll
            for (int r = 0; r < 16; ++r) { const int j = (r & 3) + 8 * (r >> 2) + 4 * h; if (j > l31) accT0[r] = 0.f; }
            OT = MFMA32(__builtin_shufflevector(vlo[0], vhi[0], 0, 1, 2, 3, 4, 5, 6, 7), pack8(accT0, 0), OT);
            OT = MFMA32(__builtin_shufflevector(vlo[1], vhi[1], 0, 1, 2, 3, 4, 5, 6, 7), pack8(accT0, 1), OT);
        }
        {
            bf16x8 vtb[2];
#pragma unroll
            for (int u = 0; u < 2; ++u) vtb[u] = *(const LAS bf16x8*)(VT + (32 * dvq + l31) * TS + 16 * u + 8 * h);
#pragma unroll
            for (int tb = 0; tb < DK / 64; ++tb) {
                bf16x8 kta[2][2];
#pragma unroll
                for (int t = 0; t < 2; ++t)
#pragma unroll
                    for (int u = 0; u < 2; ++u) kta[t][u] = *(const LAS bf16x8*)(KT + (64 * tb + 32 * t + l31) * TS + 16 * u + 8 * h);
#pragma unroll
                for (int t = 0; t < 2; ++t)
#pragma unroll
                    for (int g4 = 0; g4 < 4; ++g4) { const f32x4 d4 = *(const LAS f32x4*)(DEC + 64 * tb + 32 * t + 8 * g4 + 4 * h); const int tt = 2 * tb + t;
                        S[tt][4 * g4] *= d4.x; S[tt][4 * g4 + 1] *= d4.y; S[tt][4 * g4 + 2] *= d4.z; S[tt][4 * g4 + 3] *= d4.w; }
                SB();
#pragma unroll
                for (int u = 0; u < 2; ++u)
#pragma unroll
                    for (int t = 0; t < 2; ++t) S[2 * tb + t] = MFMA32(kta[t][u], vtb[u], S[2 * tb + t]);
            }
        }
#undef SB
        if (is_out) {
            const size_t row = orow;
            if (!second) {
#pragma unroll
                for (int g4 = 0; g4 < 4; ++g4) { u32x2 w; w.x = cvtpk(OT[4 * g4], OT[4 * g4 + 1]); w.y = cvtpk(OT[4 * g4 + 2], OT[4 * g4 + 3]);
                    *(u32x2*)(OB + ((size_t)(mcol >> 7) * MLAT + row) * 128 + 32 * dvq + 8 * g4 + 4 * h) = w; }
            } else {
                float ss = 0.f;
#pragma unroll
                for (int g4 = 0; g4 < 4; ++g4) { const u32x2 w = pob[g4];
                    OT[4 * g4] += __builtin_bit_cast(float, w.x << 16); OT[4 * g4 + 1] += __builtin_bit_cast(float, w.x & 0xffff0000u);
                    OT[4 * g4 + 2] += __builtin_bit_cast(float, w.y << 16); OT[4 * g4 + 3] += __builtin_bit_cast(float, w.y & 0xffff0000u); }
#pragma unroll
                for (int r = 0; r < 16; ++r) ss += OT[r] * OT[r];
                ss += __shfl_xor(ss, 32);
                if (h == 0) SSQ[dvq * 32 + l31] = ss;
                BAR_LDS();
                const float tot = (SSQ[l31] + SSQ[32 + l31]) + (SSQ[64 + l31] + SSQ[96 + l31]);
                const float rs = 1.0f / sqrtf(tot * (1.0f / 128.0f) + NORM_EPS);
#pragma unroll
                for (int g4 = 0; g4 < 4; ++g4) { const int vc = 32 * dvq + 8 * g4 + 4 * h;
                    const u32x2 gw = pgt[g4]; const f32x4 gn = *(const LAS f32x4*)(GN + vc);
                    const float y0 = OT[4 * g4] * rs * gn.x * __builtin_bit_cast(float, gw.x << 16), y1 = OT[4 * g4 + 1] * rs * gn.y * __builtin_bit_cast(float, gw.x & 0xffff0000u);
                    const float y2 = OT[4 * g4 + 2] * rs * gn.z * __builtin_bit_cast(float, gw.y << 16), y3 = OT[4 * g4 + 3] * rs * gn.w * __builtin_bit_cast(float, gw.y & 0xffff0000u);
                    u32x2 w; w.x = cvtpk(y0, y1); w.y = cvtpk(y2, y3);
                    *(u32x2*)(MG + row * D + mcol + vc) = w; }
            }
        }
        if (s + 1 < 72) SCAN_STORE_RAW();
        if (s == 39) __syncthreads(); else BAR_LDS();
    }
#undef SCAN_LOAD
#undef SCAN_STORE_RAW
}

__global__ void __launch_bounds__(512, 2) mega(Args a) {
    extern __shared__ __attribute__((aligned(16))) unsigned char lds_raw[];
    LAS unsigned char* lds = (LAS unsigned char*)lds_raw;
    cg::grid_group grid = cg::this_grid();
    unsigned char* ws = a.ws;
    const int lo = a.ph_lo, hi = a.ph_hi;
#define IN(k) (lo <= (k) && (k) < hi)
#define SEAM(k) do { if (IN(k) && IN((k) + 1)) grid.sync(); } while (0)
    float* xc = (float*)(ws + WS_XC); const float* mt = (const float*)(ws + WS_M);
    pg8::bf16_t* H = (pg8::bf16_t*)(ws + WS_H); pg8::bf16_t* HID = (pg8::bf16_t*)(ws + WS_FEAT); pg8::bf16_t* FEAT = (pg8::bf16_t*)(ws + WS_FEAT);
    const int G = gridDim.x, cu = blockIdx.x;

    if (IN(0)) p0_prologue(a, lds);
    SEAM(0);
    if (IN(1)) ln_pass<0>(a, 0, 0, MALL);
    SEAM(1);
    if (IN(2)) { pg8::Gemm g{H, (const pg8::bf16_t*)(ws + WS_W1IN), MALL, 2 * DFF, D}; pg8::StaticOrder S; S.init(MALL, 2 * DFF, G, cu);
        pg8::EpiSwiGLU E{HID, DFF}; pg8::gemm_phase<pg8::EpiSwiGLU, pg8::StaticOrder, true, true>(lds, g, S, E); }
    SEAM(2);
    if (IN(3)) { pg8::Gemm g{HID, (const pg8::bf16_t*)(ws + WS_W1OUT), MALL, D, DFF}; pg8::StaticOrder S; S.init(MALL, D, G, cu);
        pg8::EpiResid E{a.out, xc, mt, 2, 0.5f, DN_ALPHA, a.x, a.ctx, (const float*)(ws + WS_TAB), nullptr, nullptr, nullptr}; pg8::gemm_phase<pg8::EpiResid, pg8::StaticOrder, true, true>(lds, g, S, E); }
    SEAM(3);
    if (IN(4)) ln_pass<1>(a, 1, 0, MALL);
    SEAM(4);
    if (IN(5)) { pg8::Gemm g{H, (const pg8::bf16_t*)(ws + WS_WMIX), MALL, FW, D}; pg8::MixOrder S; S.init(G, cu);
        pg8::EpiFeat E{FEAT, FMROWS, (const float*)(ws + WS_TAB + 256 * 1024)}; pg8::gemm_phase<pg8::EpiFeat, pg8::MixOrder, true, true>(lds, g, S, E); }
    SEAM(5);
    if (IN(6)) {
        if (cu < 256) { const int item = cu; const int b = item >> 3, grp = (item >> 2) & 1, head = item & 3;
            if (grp) scan_item<128>(a, lds, b, head); else scan_item<64>(a, lds, b, head); }
    }
    SEAM(6);
    if (IN(7)) { pg8::Gemm g{H, (const pg8::bf16_t*)(ws + WS_WMO), MLAT, D, D}; pg8::StaticOrder S; S.init(MLAT, D, G, cu);
        pg8::EpiResid E{a.out, xc, mt, 5, 1.0f, DN_ALPHA, nullptr, nullptr, nullptr, (const float*)(ws + WS_STATS), a.ln_gain, a.ln_bias}; pg8::gemm_phase<pg8::EpiResid, pg8::StaticOrder, true, true>(lds, g, S, E); }
    SEAM(7);
    if (IN(8)) ln_pass<1>(a, 2, 1, MLAT);
    SEAM(8);
    if (IN(9)) { pg8::Gemm g{H, (const pg8::bf16_t*)(ws + WS_W2IN), MLAT, 2 * DFF, D}; pg8::StaticOrder S; S.init(MLAT, 2 * DFF, G, cu);
        pg8::EpiSwiGLU E{HID, DFF}; pg8::gemm_phase<pg8::EpiSwiGLU, pg8::StaticOrder, true, true>(lds, g, S, E); }
    SEAM(9);
    if (IN(10)) { pg8::Gemm g{HID, (const pg8::bf16_t*)(ws + WS_W2OUT), MLAT, D, DFF}; pg8::StaticOrder S; S.init(MLAT, D, G, cu);
        pg8::EpiResid E{a.out, xc, mt, 8, 0.5f, DN_ALPHA, nullptr, nullptr, nullptr, (const float*)(ws + WS_STATS), a.ln_gain + D, a.ln_bias + D}; pg8::gemm_phase<pg8::EpiResid, pg8::StaticOrder, true, true>(lds, g, S, E); }
    SEAM(10);
    if (IN(11)) ln_pass<2>(a, 0, 2, MLAT);
#undef IN
#undef SEAM
}

extern "C" void kernel_launch(void* const* d_in, const int* in_sizes, int n_in, void* d_out, int out_size, void* d_ws, size_t ws_size, hipStream_t stream) {
    static int grid = 0;
    if (grid == 0) {
        if (n_in != 21 || out_size != MLAT * D || ws_size < WS_END) { fprintf(stderr, "kernel_launch: unexpected shapes: n_in %d out %d ws %zu (need %zu)\n", n_in, out_size, ws_size, (size_t)WS_END); grid = -1; return; }
        int dev = 0, cus = 0, per_cu = 0;
        (void)hipGetDevice(&dev); (void)hipDeviceGetAttribute(&cus, hipDeviceAttributeMultiprocessorCount, dev);
        (void)hipFuncSetAttribute((const void*)mega, hipFuncAttributeMaxDynamicSharedMemorySize, LDS_BYTES);
        (void)hipOccupancyMaxActiveBlocksPerMultiprocessor(&per_cu, (const void*)mega, 512, LDS_BYTES);
        (void)hipGetLastError();
        grid = cus > 0 ? cus : 256; if (grid < 256) fprintf(stderr, "kernel_launch: this kernel needs >= 256 CUs (scan phase: one item per workgroup)\n");
        if (per_cu < 1) fprintf(stderr, "kernel_launch: occupancy query reports %d blocks per CU\n", per_cu);
    }
    if (grid < 0) return;
    Args a{};
    const float** p = (const float**)&a;
    for (int i = 0; i < 21; ++i) p[i] = (const float*)d_in[i];
    a.out = (float*)d_out; a.ws = (unsigned char*)d_ws; a.ph_lo = 0; a.ph_hi = 12;
    void* args[] = {&a};
    hipError_t e = hipLaunchCooperativeKernel((void*)mega, dim3(grid), dim3(512), args, LDS_BYTES, stream);
    if (e != hipSuccess) fprintf(stderr, "cooperative launch failed: %s (grid %d)\n", hipGetErrorString(e), grid);
}
```

```cpp
#include <hip/hip_runtime.h>
#include <hip/hip_cooperative_groups.h>
#include <cstdio>
#include <cstdint>
namespace cg = cooperative_groups;
namespace pg8 {
#define PG8_LAS __attribute__((address_space(3)))
typedef unsigned short bf16_t;
typedef short bf16x8 __attribute__((ext_vector_type(8)));
typedef float f32x4 __attribute__((ext_vector_type(4)));
typedef unsigned u32x4 __attribute__((ext_vector_type(4)));
constexpr int BM = 256, BK = 64, HALF = 128, HTB = HALF * BK * 2  , STAGE_BYTES = 8 * HTB, NXCD = 8, WGM = 8;

__host__ __device__ __forceinline__ int lds_byte(int r, int c) { const int st = (r >> 4) * 2 + (c >> 5), rr = r & 15, cc = c & 31, ob = rr * 64 + cc * 2; return st * 1024 + (ob ^ (((ob >> 9) & 1) << 5)); }
__host__ __device__ __forceinline__ void stage_rc(int b, int& R, int& C) { const int st = b / 1024, sb = b % 1024, swz = sb ^ (((sb >> 9) & 1) << 5); R = (st >> 1) * 16 + swz / 64; C = (st & 1) * 32 + (swz % 64) / 2; }
__host__ __device__ __forceinline__ int perm32(int rho) { const int n = rho >> 4, i = rho & 15; return 8 * (i >> 2) + 4 * n + (i & 3); }

struct Unit { int pm, pn; };
struct Gemm { const bf16_t* A; const bf16_t* Bt; int M, N, K; };

struct StaticOrder {
    int nM, nN, nwg, G, c;
    __host__ __device__ void init(int M, int N, int G_, int c_) { nM = M / BM; nN = N / BM; nwg = nM * nN; G = G_; c = c_; }
    __host__ __device__ bool next(int i, Unit& u) const {
        const long L = (long)i * G + c; if (L >= nwg) return false;
        int wgid = (int)L; { const int q = nwg / NXCD, r = nwg % NXCD, xcd = wgid % NXCD, off = wgid / NXCD; wgid = (xcd < r ? xcd * (q + 1) : r * (q + 1) + (xcd - r) * q) + off; }
        const int nig = WGM * nN, gid = wgid / nig, fm = gid * WGM, gsz = (nM - fm) < WGM ? (nM - fm) : WGM;
        u.pm = fm + ((wgid % nig) % gsz); u.pn = (wgid % nig) / gsz; return true;
    }
    __device__ __forceinline__ void a_ready(const Unit&) const {}
    __device__ __forceinline__ void done(const Unit&) const {}
};

struct MixOrder {
    StaticOrder lat; int G, c;
    __host__ __device__ void init(int G_, int c_) { lat.init(65536, 4352, G_, c_); G = G_; c = c_; }
    __host__ __device__ bool next(int i, Unit& u) const {
        const long L = (long)i * G + c; if (L < 4352) return lat.next(i, u);
        const int r = (int)(L - 4352); if (r >= 320) return false;
        const int idx = r % 10; u.pm = 256 + r / 10; u.pn = idx < 3 ? idx + 1 : (idx < 9 ? idx + 5 : 16); return true;
    }
    __device__ __forceinline__ void a_ready(const Unit&) const {}
    __device__ __forceinline__ void done(const Unit&) const {}
};
__device__ __forceinline__ unsigned cvt_pk_bf16(float lo, float hi) { unsigned r; asm volatile("v_cvt_pk_bf16_f32 %0, %1, %2" : "=v"(r) : "v"(lo), "v"(hi)); return r; }
typedef float f32x2 __attribute__((ext_vector_type(2)));
__device__ __forceinline__ float silu_f(float g) { return g * __builtin_amdgcn_rcpf(1.0f + __builtin_amdgcn_exp2f(-1.44269504089f * g)); }
__device__ __forceinline__ unsigned swiglu_pk(f32x2 g, f32x2 u) {
    const f32x2 a = g * (-1.44269504089f); f32x2 e; e.x = __builtin_amdgcn_exp2f(a.x); e.y = __builtin_amdgcn_exp2f(a.y);
    const f32x2 d = e + 1.0f; f32x2 r; r.x = __builtin_amdgcn_rcpf(d.x); r.y = __builtin_amdgcn_rcpf(d.y);
    const f32x2 o = (g * u) * r; return cvt_pk_bf16(o.x, o.y);
}
struct EpiBf16Plain {
    static constexpr bool PERM = true, AFTER_DRAIN = false;
    bf16_t* O; int ldc;
    __device__ __forceinline__ void operator()(const f32x4 (&acc)[2][2][4][2], const Unit& u, int wr, int wc, int fr, int fq) const {
        const int row0 = u.pm * BM + wr * 64 + fr; const int col0 = u.pn * BM + wc * 32 + 8 * fq;
#pragma unroll
        for (int ai = 0; ai < 2; ++ai)
#pragma unroll
            for (int m = 0; m < 4; ++m) { bf16_t* rowp = O + (size_t)(row0 + ai * HALF + m * 16) * ldc + col0;
#pragma unroll
                for (int bj = 0; bj < 2; ++bj) { const f32x4 v0 = acc[ai][bj][m][0], v1 = acc[ai][bj][m][1];
                    u32x4 w; w.x = cvt_pk_bf16(v0[0], v0[1]); w.y = cvt_pk_bf16(v0[2], v0[3]); w.z = cvt_pk_bf16(v1[0], v1[1]); w.w = cvt_pk_bf16(v1[2], v1[3]);
                    *(u32x4*)(rowp + bj * HALF) = w; } }
    }
};
struct EpiBf16Blk {
    static constexpr bool PERM = true, AFTER_DRAIN = false;
    bf16_t* O; int Mrows;
    __device__ __forceinline__ void operator()(const f32x4 (&acc)[2][2][4][2], const Unit& u, int wr, int wc, int fr, int fq) const {
        const int row0 = u.pm * BM + wr * 64 + fr; const int col0 = wc * 32 + 8 * fq;
#pragma unroll
        for (int ai = 0; ai < 2; ++ai)
#pragma unroll
            for (int m = 0; m < 4; ++m) {
#pragma unroll
                for (int bj = 0; bj < 2; ++bj) { const f32x4 v0 = acc[ai][bj][m][0], v1 = acc[ai][bj][m][1];
                    u32x4 w; w.x = cvt_pk_bf16(v0[0], v0[1]); w.y = cvt_pk_bf16(v0[2], v0[3]); w.z = cvt_pk_bf16(v1[0], v1[1]); w.w = cvt_pk_bf16(v1[2], v1[3]);
                    *(u32x4*)(O + ((size_t)(2 * u.pn + bj) * Mrows + (row0 + ai * HALF + m * 16)) * 128 + col0) = w; } }
    }
};
struct EpiFeat {
    static constexpr bool PERM = true, AFTER_DRAIN = false;
    bf16_t* O; int Mrows; const float* oml;
    __device__ __forceinline__ void operator()(const f32x4 (&acc)[2][2][4][2], const Unit& u, int wr, int wc, int fr, int fq) const {
        const int row0 = u.pm * BM + wr * 64 + fr + (u.pm < 256 ? (u.pm >> 3) * 36 : 1152); const int col0 = wc * 32 + 8 * fq; const int pn = u.pn;
        const int mode = pn == 0 ? 1 : ((pn == 6 || pn == 7) ? 2 : ((pn >= 8 && pn <= 11) ? 3 : ((pn == 4 || pn == 5 || pn == 14 || pn == 15) ? 4 : 0)));
        const float* omp = oml + (pn >= 10 ? 512 : 0) + (pn & 1) * 256 + col0;
#pragma unroll
        for (int ai = 0; ai < 2; ++ai)
#pragma unroll
            for (int m = 0; m < 4; ++m) {
#pragma unroll
                for (int bj = 0; bj < 2; ++bj) { f32x4 v0 = acc[ai][bj][m][0], v1 = acc[ai][bj][m][1];
                    if (mode == 1) { v0 = v0 * 0.125f; v1 = v1 * 0.125f; }
                    else if (mode == 2) {
#pragma unroll
                        for (int e = 0; e < 4; ++e) { v0[e] = silu_f(v0[e]) * 0.08838834764831845f; v1[e] = silu_f(v1[e]) * 0.08838834764831845f; } }
                    else if (mode == 4) {
#pragma unroll
                        for (int e = 0; e < 4; ++e) { v0[e] = silu_f(v0[e]); v1[e] = silu_f(v1[e]); } }
                    else if (mode == 3) { const f32x4 o0 = *(const f32x4*)(omp + bj * HALF), o1 = *(const f32x4*)(omp + bj * HALF + 4);
#pragma unroll
                        for (int e = 0; e < 4; ++e) { v0[e] = o0[e] * __builtin_amdgcn_rcpf(1.0f + __builtin_amdgcn_exp2f(1.44269504089f * v0[e]));
                                                      v1[e] = o1[e] * __builtin_amdgcn_rcpf(1.0f + __builtin_amdgcn_exp2f(1.44269504089f * v1[e])); } }
                    u32x4 w; w.x = cvt_pk_bf16(v0[0], v0[1]); w.y = cvt_pk_bf16(v0[2], v0[3]); w.z = cvt_pk_bf16(v1[0], v1[1]); w.w = cvt_pk_bf16(v1[2], v1[3]);
                    *(u32x4*)(O + ((size_t)(2 * pn + bj) * Mrows + (row0 + ai * HALF + m * 16)) * 128 + col0) = w; } }
    }
};
struct EpiSwiGLU {
    static constexpr bool PERM = true, AFTER_DRAIN = false;
    bf16_t* O; int ldc;
    __device__ __forceinline__ void operator()(const f32x4 (&acc)[2][2][4][2], const Unit& u, int wr, int wc, int fr, int fq) const {
        const int row0 = u.pm * BM + wr * 64 + fr; const int col0 = u.pn * HALF + wc * 32 + 8 * fq;
#pragma unroll
        for (int ai = 0; ai < 2; ++ai)
#pragma unroll
            for (int m = 0; m < 4; ++m) { bf16_t* rowp = O + (size_t)(row0 + ai * HALF + m * 16) * ldc + col0;
                const f32x4 g0 = acc[ai][0][m][0], g1 = acc[ai][0][m][1], u0 = acc[ai][1][m][0], u1 = acc[ai][1][m][1];
                u32x4 w;
                w.x = swiglu_pk((f32x2){g0[0], g0[1]}, (f32x2){u0[0], u0[1]}); w.y = swiglu_pk((f32x2){g0[2], g0[3]}, (f32x2){u0[2], u0[3]});
                w.z = swiglu_pk((f32x2){g1[0], g1[1]}, (f32x2){u1[0], u1[1]}); w.w = swiglu_pk((f32x2){g1[2], g1[3]}, (f32x2){u1[2], u1[3]});
                *(u32x4*)rowp = w; }
    }
};
struct EpiResid {
    static constexpr bool PERM = false, AFTER_DRAIN = false;
    float* Xlat; float* Xctx; const float* mtab; int gate_idx; float w; float alpha; const float* srcLat; const float* srcCtx; const float* tab;
    const float* stats; const float* lng; const float* lnb;
    __device__ __forceinline__ void operator()(const f32x4 (&acc)[2][2][4][2], const Unit& u, int wr, int wc, int fr, int fq) const {
        const bool lat = u.pm < 256; const int b = lat ? (u.pm >> 3) : 32;
        const float* g = mtab + ((size_t)b * 9 + gate_idx) * 1024;
        const size_t toff = lat ? (size_t)u.pm * BM * 1024 : (size_t)(u.pm - 256) * BM * 1024;
        float* X = (lat ? Xlat : Xctx) + toff;
        const float* R = srcLat ? (lat ? srcLat : srcCtx) + toff : X;
        const bool addpos = srcLat != nullptr && lat;
        const int col0 = u.pn * BM + wc * 32 + 4 * fq;
#pragma unroll
        for (int bj = 0; bj < 2; ++bj)
#pragma unroll
            for (int n = 0; n < 2; ++n) { const int col = col0 + bj * HALF + n * 16; f32x4 gv = *(const f32x4*)(g + col); gv = gv * w;
                f32x4 lg4 = (f32x4){1.f, 1.f, 1.f, 1.f}, lb4 = (f32x4){0.f, 0.f, 0.f, 0.f};
                if (stats) { lg4 = *(const f32x4*)(lng + col); lb4 = *(const f32x4*)(lnb + col); }
#pragma unroll
                for (int ai = 0; ai < 2; ++ai)
#pragma unroll
                    for (int m = 0; m < 4; ++m) { const int rl = ai * HALF + wr * 64 + m * 16 + fr;
                        f32x4 xv = *(const f32x4*)(R + (size_t)rl * 1024 + col);
                        if (stats) { const f32x2 st = *(const f32x2*)(stats + 2 * ((size_t)u.pm * BM + rl)); xv = (xv - st.x) * st.y * lg4 + lb4; }
                        if (addpos) { const int t = (u.pm * BM + rl) & 2047; xv += *(const f32x4*)(tab + (u.pn < 2 ? (t >> 6) * 512 + col : (t & 63) * 512 + col - 512)); }
                        *(f32x4*)(X + (size_t)rl * 1024 + col) = xv * alpha + gv * acc[ai][bj][m][n]; } }
    }
};
template <class Epi, class Sched, bool ALIGN_EPI = false, bool SP2 = false>
__device__ __forceinline__ void gemm_phase(PG8_LAS unsigned char* lds, const Gemm g, const Sched& S, const Epi& E) {
    const int tid = threadIdx.x, wid = __builtin_amdgcn_readfirstlane(tid >> 6), lane = tid & 63, wr = wid >> 2, wc = wid & 3, fr = lane & 15, fq = lane >> 4;
    const int K = g.K, nt = K / BK;
    unsigned voffA[2], voffB[2];
#pragma unroll
    for (int i = 0; i < 2; ++i) { int R, C; stage_rc(tid * 16 + i * 8192, R, C); const int Rb = Epi::PERM ? ((R & ~31) + perm32(R & 31)) : R;
        voffA[i] = (unsigned)(R * K + C) * 2u; voffB[i] = (unsigned)(Rb * K + C) * 2u; }
    const size_t kstep = (size_t)(BK * 2);
    const size_t hstep = (size_t)HALF * K * 2;
    const size_t tstep = 2 * hstep;
    const unsigned ldsw = (unsigned)wid * 1024u;
    const int aoff = lds_byte(wr * 64 + fr, fq * 8), boff = lds_byte(wc * 32 + fr, fq * 8);
#define PG8_SA(b, h) (((b) * 2 + (h)) * HTB)
#define PG8_SB(b, h) ((4 + (b) * 2 + (h)) * HTB)
#define PG8_STAGE(bufoff, gbase, voff) do { _Pragma("unroll") for (int _i = 0; _i < 2; ++_i) \
        __builtin_amdgcn_global_load_lds((const unsigned*)((const char*)(gbase) + (voff)[_i]), (PG8_LAS unsigned*)(lds + (bufoff) + ldsw + _i * 8192), 16, 0, 0); } while (0)
#define PG8_LDA(dst, b, h) do { _Pragma("unroll") for (int m = 0; m < 4; ++m) _Pragma("unroll") for (int k = 0; k < 2; ++k) dst[m][k] = *(const PG8_LAS bf16x8*)(lds + PG8_SA(b, h) + aoff + m * 2048 + k * 1024); } while (0)
#define PG8_LDB(dst, b, h) do { _Pragma("unroll") for (int n = 0; n < 2; ++n) _Pragma("unroll") for (int k = 0; k < 2; ++k) dst[n][k] = *(const PG8_LAS bf16x8*)(lds + PG8_SB(b, h) + boff + n * 2048 + k * 1024); } while (0)
#define PG8_MMA(ai, bj, At, Bt) do { __builtin_amdgcn_s_setprio(1); _Pragma("unroll") for (int m = 0; m < 4; ++m) _Pragma("unroll") for (int n = 0; n < 2; ++n) _Pragma("unroll") for (int k = 0; k < 2; ++k) \
        acc[ai][bj][m][n] = __builtin_amdgcn_mfma_f32_16x16x32_bf16(Bt[n][k], At[m][k], acc[ai][bj][m][n], 0, 0, 0); __builtin_amdgcn_s_setprio(0); } while (0)
#define PG8_WAIT_V(n) asm volatile("s_waitcnt vmcnt(" #n ")" ::: "memory")
#define PG8_WAIT_L(n) asm volatile("s_waitcnt lgkmcnt(" #n ")" ::: "memory")
#define PG8_BAR __builtin_amdgcn_s_barrier()
#define PG8_SCHED __builtin_amdgcn_sched_barrier(0)
    Unit cur, nxt; int ui = 0;
    if (!S.next(0, cur)) return;
    f32x4 acc[2][2][4][2];
#pragma unroll
    for (int a = 0; a < 2; ++a)
#pragma unroll
        for (int b = 0; b < 2; ++b)
#pragma unroll
            for (int m = 0; m < 4; ++m)
#pragma unroll
                for (int n = 0; n < 2; ++n) acc[a][b][m][n] = (f32x4){0.f, 0.f, 0.f, 0.f};
    bf16x8 At[4][2], B0[2][2], B1[2][2];
    const char* cA = (const char*)g.A + (size_t)cur.pm * tstep; const char* cB = (const char*)g.Bt + (size_t)cur.pn * tstep;
    S.a_ready(cur);
    if constexpr (SP2) {
        PG8_STAGE(PG8_SB(0, 0), cB, voffB); PG8_STAGE(PG8_SB(0, 1), cB + hstep, voffB); PG8_STAGE(PG8_SA(0, 0), cA, voffA); PG8_STAGE(PG8_SA(0, 1), cA + hstep, voffA);
        if (wr == 1) PG8_BAR;
        PG8_WAIT_V(2); PG8_BAR;
        PG8_STAGE(PG8_SB(1, 0), cB + kstep, voffB); PG8_STAGE(PG8_SA(1, 0), cA + kstep, voffA); PG8_STAGE(PG8_SB(1, 1), cB + hstep + kstep, voffB);
        PG8_WAIT_V(6); PG8_BAR;
    } else {
        PG8_STAGE(PG8_SB(0, 0), cB, voffB); PG8_STAGE(PG8_SA(0, 0), cA, voffA); PG8_STAGE(PG8_SB(0, 1), cB + hstep, voffB); PG8_STAGE(PG8_SA(0, 1), cA + hstep, voffA);
        if (wr == 1) PG8_BAR;
        PG8_WAIT_V(4); PG8_BAR;
        PG8_STAGE(PG8_SB(1, 0), cB + kstep, voffB); PG8_STAGE(PG8_SA(1, 0), cA + kstep, voffA); PG8_STAGE(PG8_SB(1, 1), cB + hstep + kstep, voffB);
        PG8_WAIT_V(6); PG8_BAR;
    }
    for (;;) {
        const bool has_next = S.next(ui + 1, nxt);
        const char* nA = has_next ? (const char*)g.A + (size_t)nxt.pm * tstep : cA; const char* nB = has_next ? (const char*)g.Bt + (size_t)nxt.pn * tstep : cB;
        for (int t = 0; t < nt; t += 2) {
            const bool last = (t == nt - 2);
            const char* a1 = cA + (size_t)(t + 1) * kstep;
            const char* a2 = last ? nA : cA + (size_t)(t + 2) * kstep; const char* b2 = last ? nB : cB + (size_t)(t + 2) * kstep;
            const char* a3 = a2 + kstep; const char* b3 = b2 + kstep;
            if (last && has_next) S.a_ready(nxt);
            if constexpr (SP2) {
            PG8_LDB(B0, 0, 0); PG8_LDB(B1, 0, 1); PG8_SCHED; PG8_LDA(At, 0, 0); PG8_STAGE(PG8_SA(1, 1), a1 + hstep, voffA);
            PG8_WAIT_V(8); PG8_WAIT_L(0); PG8_BAR; PG8_MMA(0, 0, At, B0); PG8_MMA(0, 1, At, B1); PG8_BAR; PG8_SCHED;
            PG8_LDA(At, 0, 1); PG8_STAGE(PG8_SB(0, 0), b2, voffB); PG8_STAGE(PG8_SB(0, 1), b2 + hstep, voffB); PG8_STAGE(PG8_SA(0, 0), a2, voffA);
            PG8_WAIT_V(8); PG8_WAIT_L(0); PG8_BAR; PG8_MMA(1, 0, At, B0); PG8_MMA(1, 1, At, B1); PG8_BAR; PG8_SCHED;
            PG8_LDB(B0, 1, 0); PG8_LDB(B1, 1, 1); PG8_SCHED; PG8_LDA(At, 1, 0); PG8_STAGE(PG8_SA(0, 1), a2 + hstep, voffA);
            PG8_WAIT_V(8); PG8_WAIT_L(0); PG8_BAR; PG8_MMA(0, 0, At, B0); PG8_MMA(0, 1, At, B1); PG8_BAR; PG8_SCHED;
            PG8_LDA(At, 1, 1); PG8_STAGE(PG8_SB(1, 0), b3, voffB); PG8_STAGE(PG8_SB(1, 1), b3 + hstep, voffB); PG8_STAGE(PG8_SA(1, 0), a3, voffA);
            PG8_WAIT_V(8); PG8_WAIT_L(0); PG8_BAR; PG8_MMA(1, 0, At, B0); PG8_MMA(1, 1, At, B1); PG8_BAR; PG8_SCHED;
            } else {
            PG8_LDB(B0, 0, 0); PG8_SCHED; PG8_LDA(At, 0, 0); PG8_STAGE(PG8_SA(1, 1), a1 + hstep, voffA);
            PG8_WAIT_L(8); PG8_BAR; PG8_WAIT_L(0); PG8_MMA(0, 0, At, B0); PG8_BAR; PG8_SCHED;
            PG8_LDB(B1, 0, 1); PG8_STAGE(PG8_SB(0, 0), b2, voffB);
            PG8_BAR; PG8_WAIT_L(0); PG8_MMA(0, 1, At, B1); PG8_BAR;
            PG8_LDA(At, 0, 1); PG8_STAGE(PG8_SA(0, 0), a2, voffA);
            PG8_BAR; PG8_WAIT_L(0); PG8_MMA(1, 0, At, B0); PG8_BAR; PG8_SCHED;
            PG8_STAGE(PG8_SB(0, 1), b2 + hstep, voffB);
            PG8_WAIT_V(6); PG8_BAR; PG8_MMA(1, 1, At, B1); PG8_BAR;
            PG8_LDB(B0, 1, 0); PG8_SCHED; PG8_LDA(At, 1, 0); PG8_STAGE(PG8_SA(0, 1), a2 + hstep, voffA);
            PG8_WAIT_L(8); PG8_BAR; PG8_WAIT_L(0); PG8_MMA(0, 0, At, B0); PG8_BAR; PG8_SCHED;
            PG8_LDB(B1, 1, 1); PG8_STAGE(PG8_SB(1, 0), b3, voffB);
            PG8_BAR; PG8_WAIT_L(0); PG8_MMA(0, 1, At, B1); PG8_BAR;
            PG8_LDA(At, 1, 1); PG8_STAGE(PG8_SA(1, 0), a3, voffA);
            PG8_BAR; PG8_WAIT_L(0); PG8_MMA(1, 0, At, B0); PG8_BAR; PG8_SCHED;
            PG8_STAGE(PG8_SB(1, 1), b3 + hstep, voffB);
            PG8_WAIT_V(6); PG8_BAR; PG8_MMA(1, 1, At, B1); PG8_BAR;
            }
        }
        if constexpr (ALIGN_EPI) { if (wr == 0) PG8_BAR; }
        if constexpr (!Epi::AFTER_DRAIN) { E(acc, cur, wr, wc, fr, fq); S.done(cur); }
        if (!has_next) break;
#pragma unroll
        for (int a = 0; a < 2; ++a)
#pragma unroll
            for (int b = 0; b < 2; ++b)
#pragma unroll
                for (int m = 0; m < 4; ++m)
#pragma unroll
                    for (int n = 0; n < 2; ++n) acc[a][b][m][n] = (f32x4){0.f, 0.f, 0.f, 0.f};
        cur = nxt; cA = nA; cB = nB; ++ui;
        if constexpr (ALIGN_EPI) { if (wr == 1) PG8_BAR; }
    }
    PG8_WAIT_V(0);
    if constexpr (!ALIGN_EPI) { if (wr == 0) PG8_BAR; }
    PG8_BAR;
    if constexpr (Epi::AFTER_DRAIN) { E.fused(acc, cur, wr, wc, fr, fq, lds, wid, lane); S.done(cur); }
#undef PG8_SA
#undef PG8_SB
#undef PG8_STAGE
#undef PG8_LDA
#undef PG8_LDB
#undef PG8_MMA
#undef PG8_WAIT_V
#undef PG8_WAIT_L
#undef PG8_BAR
#undef PG8_SCHED
}
}

#define LAS __attribute__((address_space(3)))
typedef unsigned short bf16;
typedef float f32x4 __attribute__((ext_vector_type(4)));
typedef float f32x16 __attribute__((ext_vector_type(16)));
typedef short bf16x8 __attribute__((ext_vector_type(8)));
typedef short s16x4 __attribute__((ext_vector_type(4)));
typedef unsigned u32x4 __attribute__((ext_vector_type(4)));
typedef unsigned u32x2 __attribute__((ext_vector_type(2)));

constexpr int D = 1024, NB = 32, T = 2048, TC = 256, DFF = 2816;
constexpr int MLAT = NB * T, MCTX = NB * TC, MALL = MLAT + MCTX;
constexpr int FMROWS = 75008;
constexpr int FW = 4352;
constexpr int GQ = 0, GK = 256, GV = 512, GG = 1024, HQ = 1536, HFF = 2048, HFB = 2560, HI = 3072, HG = 3584, LRF = 4096, LRB = 4112;
constexpr float LN_EPS = 1e-5f, NORM_EPS = 1e-6f;
constexpr float DN_ALPHA = 1.189207115002721f;
constexpr size_t MiB = 1u << 20;
constexpr size_t WS_M = 0, WS_TAB = 2 * MiB, WS_W1IN = 3 * MiB, WS_W1OUT = 14 * MiB, WS_WMIX = 20 * MiB, WS_WMO = 29 * MiB, WS_W2IN = 31 * MiB, WS_W2OUT = 42 * MiB,
                 WS_XC = 48 * MiB, WS_H = 80 * MiB, WS_OB = 224 * MiB, WS_FEAT = 352 * MiB, WS_END = 976 * MiB;
constexpr size_t WS_STATS = WS_TAB + 384 * 1024;
constexpr size_t WS_BAR = WS_M + 1536 * 1024;
constexpr int LDS_BYTES = 147456;

struct Args {
    const float *x, *c, *ctx, *c_ctx, *w_ada, *b_ada, *ln_gain, *ln_bias, *ffn1_w_in, *ffn1_w_out, *w_mix_in, *a2_f, *a2_b, *abias_f, *abias_b, *lb_logits,
                *gla_gain, *hgrn_gain, *w_mix_out, *ffn2_w_in, *ffn2_w_out;
    float* out; unsigned char* ws; int ph_lo, ph_hi;
};

__device__ __forceinline__ unsigned f2bf(float f) { unsigned u = __builtin_bit_cast(unsigned, f); return (u + 0x7fffu + ((u >> 16) & 1u)) >> 16; }
__device__ __forceinline__ unsigned pk2(float lo, float hi) { return f2bf(lo) | (f2bf(hi) << 16); }
__device__ __forceinline__ float bf2f(unsigned short v) { return __builtin_bit_cast(float, (unsigned)v << 16); }
__device__ __forceinline__ float wave_sum(float v) {
#pragma unroll
    for (int o = 1; o < 64; o <<= 1) v += __shfl_xor(v, o);
    return v;
}
#define LDS_WAIT() asm volatile("s_waitcnt lgkmcnt(0)" ::: "memory")

__device__ __forceinline__ int remap_row(int kind, int n) {
    if (kind == 1) { const int half = n >= DFF ? 1 : 0, j = n - half * DFF; return 256 * (j >> 7) + 128 * half + (j & 127); }
    if (kind == 2) { return n < 1536 ? n : (n < 1568 ? 4096 + (n - 1536) : n - 32); }
    return n;
}
__device__ __forceinline__ void p0_transpose_item(const float* W, int K, int N, bf16* WT, int kind, LAS float* scr, int item, int lane) {
    const int nblk = N / 32, kb = item / nblk, nb = item % nblk, k0 = 64 * kb, n0 = 32 * nb;
    const int r0 = remap_row(kind, n0);
#pragma unroll 8
    for (int i = 0; i < 32; ++i) { const int kk = 2 * i + (lane >> 5); scr[kk * 33 + (lane & 31)] = W[(size_t)(k0 + kk) * N + n0 + (lane & 31)]; }
    LDS_WAIT(); asm volatile("" ::: "memory");
    const int c = lane & 7;
#pragma unroll
    for (int j = 0; j < 4; ++j) { const int n = (lane >> 3) + 8 * j; const LAS float* s = scr + (8 * c) * 33 + n;
        u32x4 o; o.x = pk2(s[0 * 33], s[1 * 33]); o.y = pk2(s[2 * 33], s[3 * 33]); o.z = pk2(s[4 * 33], s[5 * 33]); o.w = pk2(s[6 * 33], s[7 * 33]);
        *(u32x4*)(WT + (size_t)(r0 + n) * K + k0 + 8 * c) = o; }
    LDS_WAIT(); asm volatile("" ::: "memory");
}
__device__ __forceinline__ void p0_prologue(const Args& a, LAS unsigned char* lds) {
    const int tid = threadIdx.x, lane = tid & 63, wave = tid >> 6;
    const int G = gridDim.x, gw = blockIdx.x * 8 + wave, NGW = G * 8;
    unsigned char* ws = a.ws;
    {
        LAS float* scr = (LAS float*)(lds + wave * 16384);
        constexpr int I_IN = (D / 64) * (2 * DFF / 32), I_OUT = (DFF / 64) * (D / 32), I_MIX = (D / 64) * (4128 / 32), I_MO = (D / 64) * (D / 32);
        constexpr int NITEMS = 2 * I_IN + 2 * I_OUT + I_MIX + I_MO;
        for (int it = gw; it < NITEMS; it += NGW) {
            int r = it;
            if (r < I_IN) { p0_transpose_item(a.ffn1_w_in, D, 2 * DFF, (bf16*)(ws + WS_W1IN), 1, scr, r, lane); continue; } r -= I_IN;
            if (r < I_IN) { p0_transpose_item(a.ffn2_w_in, D, 2 * DFF, (bf16*)(ws + WS_W2IN), 1, scr, r, lane); continue; } r -= I_IN;
            if (r < I_OUT) { p0_transpose_item(a.ffn1_w_out, DFF, D, (bf16*)(ws + WS_W1OUT), 0, scr, r, lane); continue; } r -= I_OUT;
            if (r < I_OUT) { p0_transpose_item(a.ffn2_w_out, DFF, D, (bf16*)(ws + WS_W2OUT), 0, scr, r, lane); continue; } r -= I_OUT;
            if (r < I_MIX) { p0_transpose_item(a.w_mix_in, D, 4128, (bf16*)(ws + WS_WMIX), 2, scr, r, lane); continue; } r -= I_MIX;
            p0_transpose_item(a.w_mix_out, D, D, (bf16*)(ws + WS_WMO), 0, scr, r, lane);
        }
        u32x4* z = (u32x4*)((bf16*)(ws + WS_WMIX) + (size_t)4128 * D);
        for (int i = blockIdx.x * 512 + tid; i < 224 * D / 8; i += G * 512) z[i] = (u32x4){0u, 0u, 0u, 0u};
        float* tab = (float*)(ws + WS_TAB);
        for (int i = blockIdx.x * 512 + tid; i < 64 * 256; i += G * 512) { const int p = i >> 8, q = i & 255;
            const float omega = 1.0f / powf(10000.0f, (float)q * (1.0f / 256.0f)); const float ang = (float)p * omega;
            tab[p * 512 + q] = sinf(ang); tab[p * 512 + 256 + q] = cosf(ang); }
    }
    {
        float* oml = (float*)(ws + WS_TAB + 256 * 1024);
        for (int i = blockIdx.x * 512 + tid; i < 1024; i += G * 512) { const int dr = i >> 9, k = i & 511; const float l0 = a.lb_logits[dr * 1024 + k], l1 = a.lb_logits[dr * 1024 + 512 + k];
            oml[i] = 1.0f - 1.0f / (1.0f + expf(l1 - l0)); }
    }
    __syncthreads();
    for (int item = blockIdx.x; item < 9216 / 64; item += G) {
        LAS float* sc = (LAS float*)lds;
        for (int i = tid; i < 33 * 1024; i += 512) { const float v = i < 32 * 1024 ? a.c[i] : a.c_ctx[i - 32 * 1024]; sc[i] = v / (1.0f + __expf(-v)); }
        __syncthreads();
        float acc[33];
#pragma unroll
        for (int b = 0; b < 33; ++b) acc[b] = 0.f;
        const int n = item * 64 + lane;
        for (int k = wave * 128; k < wave * 128 + 128; ++k) { const float wv = a.w_ada[(size_t)k * 9216 + n];
#pragma unroll
            for (int b = 0; b < 33; ++b) acc[b] += sc[b * 1024 + k] * wv; }
        __syncthreads();
        LAS float* red = (LAS float*)lds;
#pragma unroll
        for (int b = 0; b < 33; ++b) red[(wave * 33 + b) * 64 + lane] = acc[b];
        __syncthreads();
        float* mt = (float*)(ws + WS_M);
        for (int i = tid; i < 33 * 64; i += 512) { const int b = i >> 6, l = i & 63; float s = 0.f;
#pragma unroll
            for (int w = 0; w < 8; ++w) s += red[(w * 33 + b) * 64 + l];
            mt[(size_t)b * 9216 + item * 64 + l] = s + a.b_ada[item * 64 + l]; }
        __syncthreads();
    }
}

template <int MODE>
__device__ __forceinline__ void ln_load(const Args& a, int r, int lane, f32x4 (&v)[4]) {
    const bool lat = r < MLAT;
    if (MODE == 0) {
        const float* src = lat ? a.x + (size_t)r * D : a.ctx + (size_t)(r - MLAT) * D;
#pragma unroll
        for (int j = 0; j < 4; ++j) v[j] = *((const f32x4*)src + lane + 64 * j);
    } else {
        const float* Xrow = lat ? a.out + (size_t)r * D : (const float*)(a.ws + WS_XC) + (size_t)(r - MLAT) * D;
#pragma unroll
        for (int j = 0; j < 4; ++j) v[j] = *((const f32x4*)Xrow + lane + 64 * j);
    }
}
template <int MODE>
__device__ __forceinline__ void ln_finish(const Args& a, int sub, int li, int r, int lane, f32x4 (&v)[4]) {
    const float* mt = (const float*)(a.ws + WS_M);
    const float* tab = (const float*)(a.ws + WS_TAB);
    bf16* H = (bf16*)(a.ws + WS_H);
    const bool lat = r < MLAT; const int b = lat ? (r >> 11) : 32;
    float* Xrow = lat ? a.out + (size_t)r * D : (float*)(a.ws + WS_XC) + (size_t)(r - MLAT) * D;
    if (MODE == 0) {
        if (lat) { const int t = r & 2047; const float* tr = tab + (t >> 6) * 512; const float* tcl = tab + (t & 63) * 512;
            v[0] += *((const f32x4*)tr + lane); v[1] += *((const f32x4*)tr + lane + 64); v[2] += *((const f32x4*)tcl + lane); v[3] += *((const f32x4*)tcl + lane + 64); }
    } else {
        float s = 0.f;
#pragma unroll
        for (int j = 0; j < 4; ++j) s += (v[j].x + v[j].y) + (v[j].z + v[j].w);
        const float mean = wave_sum(s) * (1.f / D); float s2 = 0.f;
#pragma unroll
        for (int j = 0; j < 4; ++j) { v[j] = v[j] - mean; s2 += (v[j].x * v[j].x + v[j].y * v[j].y) + (v[j].z * v[j].z + v[j].w * v[j].w); }
        const float rstd = 1.f / sqrtf(wave_sum(s2) * (1.f / D) + LN_EPS);
        const float* gn = a.ln_gain + li * D; const float* bs = a.ln_bias + li * D;
#pragma unroll
        for (int j = 0; j < 4; ++j) { const f32x4 g4 = *((const f32x4*)gn + lane + 64 * j), b4 = *((const f32x4*)bs + lane + 64 * j); v[j] = v[j] * rstd * g4 + b4; if (MODE == 2) *((f32x4*)Xrow + lane + 64 * j) = v[j]; }
        if (MODE == 1 && lane == 0) { float* st = (float*)(a.ws + WS_STATS) + 2 * (size_t)r; st[0] = mean; st[1] = rstd; }
    }
    if (MODE != 2) {
        float s = 0.f;
#pragma unroll
        for (int j = 0; j < 4; ++j) s += (v[j].x + v[j].y) + (v[j].z + v[j].w);
        const float mean = wave_sum(s) * (1.f / D); float s2 = 0.f;
#pragma unroll
        for (int j = 0; j < 4; ++j) { v[j] = v[j] - mean; s2 += (v[j].x * v[j].x + v[j].y * v[j].y) + (v[j].z * v[j].z + v[j].w * v[j].w); }
        const float rstd = 1.f / sqrtf(wave_sum(s2) * (1.f / D) + LN_EPS);
        const float* m0 = mt + ((size_t)b * 9 + 3 * sub) * D; const float* m1 = m0 + D;
        u32x2* o8 = (u32x2*)(H + (size_t)r * D) + lane;
#pragma unroll
        for (int j = 0; j < 4; ++j) { const f32x4 s4 = *((const f32x4*)m0 + lane + 64 * j), t4 = *((const f32x4*)m1 + lane + 64 * j);
            const f32x4 h = v[j] * rstd * (s4 + 1.0f) + t4; u32x2 w; w.x = pk2(h.x, h.y); w.y = pk2(h.z, h.w); o8[64 * j] = w; }
    }
}
template <int MODE>
__device__ __forceinline__ void ln_pass(const Args& a, int sub, int li, int nrows) {
    const int tid = threadIdx.x, lane = tid & 63, wave = tid >> 6;
    const int gw = blockIdx.x * 8 + wave, NGW = gridDim.x * 8;
    for (int r = gw; r < nrows; r += 2 * NGW) {
        const int r2 = r + NGW; const bool two = r2 < nrows;
        f32x4 va[4], vb[4];
        ln_load<MODE>(a, r, lane, va);
        if (two) ln_load<MODE>(a, r2, lane, vb);
        ln_finish<MODE>(a, sub, li, r, lane, va);
        if (two) ln_finish<MODE>(a, sub, li, r2, lane, vb);
    }
}
__device__ __forceinline__ float silu_q(float g) { return g * __builtin_amdgcn_rcpf(1.0f + __expf(-g)); }

#define XB_TMO      128
#define XB_XCNT(j)  (256  + 64 * (j))
#define XB_XSUB(j)  (1280 + 64 * (j))
#define XB_XGEN(j)  (2304 + 64 * (j))
#define XB_TOP      3328
#define XB_TOPGEN   3392
#define XCD_BAR_WORDS 3456
#define XB_SPIN_CAP (1u << 18)

__device__ __forceinline__ unsigned xb_ld(unsigned* p)              { return __hip_atomic_load(p, __ATOMIC_RELAXED, __HIP_MEMORY_SCOPE_AGENT); }
__device__ __forceinline__ unsigned xb_add(unsigned* p, unsigned v) { return __hip_atomic_fetch_add(p, v, __ATOMIC_RELAXED, __HIP_MEMORY_SCOPE_AGENT); }
__device__ __forceinline__ unsigned xb_xcc_id() { return (unsigned)__builtin_amdgcn_s_getreg((3 << 11) | 20) & 0xFu; }
#define XB_SPIN(cond, bar) do { unsigned _sp = 0; while (cond) { __builtin_amdgcn_s_sleep(1); \
    if ((++_sp & 255u) == 0u) { if (xb_ld(&(bar)[XB_TMO])) break; if (_sp > XB_SPIN_CAP) { atomicAdd(&(bar)[XB_TMO], 1u); break; } } } } while (0)

struct XcdBarrier {
    unsigned* bar; unsigned x;
    volatile LAS unsigned* st;
};

__device__ __forceinline__ XcdBarrier xcd_barrier_post(unsigned* bar, volatile LAS unsigned* st) {
    XcdBarrier b; b.bar = bar; b.x = xb_xcc_id(); b.st = st;
    if (threadIdx.x == 0) (void)xb_add(&bar[XB_XCNT(b.x)], 1u);
    return b;
}
__device__ __forceinline__ void xcd_barrier_complete(unsigned* bar, unsigned x, unsigned& nloc, unsigned& nx) {
    const unsigned G = gridDim.x * gridDim.y * gridDim.z;
    unsigned sum, cnt, mine, sp = 0u;
    for (;;) {
        sum = 0u; cnt = 0u; mine = 0u;
#pragma unroll
        for (unsigned j = 0; j < 16; ++j) { const unsigned c = xb_ld(&bar[XB_XCNT(j)]); sum += c; cnt += (c > 0u) ? 1u : 0u; mine = (j == x) ? c : mine; }
        if (sum == G) break;
        __builtin_amdgcn_s_sleep(1);
        if ((++sp & 255u) == 0u) { if (xb_ld(&bar[XB_TMO])) break; if (sp > XB_SPIN_CAP) { atomicAdd(&bar[XB_TMO], 1u); break; } }
    }
    nloc = mine > 0u ? mine : 1u; nx = cnt > 0u ? cnt : 1u;
}

__device__ __forceinline__ void xcd_barrier(const XcdBarrier& b) {
    asm volatile("s_waitcnt vmcnt(0)" ::: "memory");
    __syncthreads();
    if (threadIdx.x == 0) {
        unsigned* bar = b.bar;
        __builtin_amdgcn_s_waitcnt(0);
        unsigned nloc = b.st[0], nx = b.st[1];
        if (nloc == 0u) { xcd_barrier_complete(bar, b.x, nloc, nx); b.st[0] = nloc; b.st[1] = nx; }
        const unsigned old = xb_add(&bar[XB_XSUB(b.x)], 1u);
        const unsigned gen = old / nloc;
        if (old + 1u == (gen + 1u) * nloc) {
            __builtin_amdgcn_fence(__ATOMIC_RELEASE, "agent");
            asm volatile("s_waitcnt vmcnt(0)" ::: "memory");
            const unsigned og = xb_add(&bar[XB_TOP], 1u);
            const unsigned tg = og / nx;
            if (og + 1u == (tg + 1u) * nx) xb_add(&bar[XB_TOPGEN], 1u);
            else XB_SPIN(xb_ld(&bar[XB_TOPGEN]) == tg, bar);
            __builtin_amdgcn_fence(__ATOMIC_ACQUIRE, "agent");
            xb_add(&bar[XB_XGEN(b.x)], 1u);
            asm volatile("s_waitcnt vmcnt(0)" ::: "memory");
        } else {
            XB_SPIN(xb_ld(&bar[XB_XGEN(b.x)]) == gen, bar);
            __builtin_amdgcn_fence(__ATOMIC_ACQUIRE, "agent");
            asm volatile("s_waitcnt vmcnt(0)" ::: "memory");
        }
    }
    __syncthreads();
}


#define BAR_LDS() do { asm volatile("s_waitcnt lgkmcnt(0)" ::: "memory"); __builtin_amdgcn_s_barrier(); asm volatile("" ::: "memory"); } while (0)
#define MFMA32(a_, b_, c_) __builtin_amdgcn_mfma_f32_32x32x16_bf16((a_), (b_), (c_), 0, 0, 0)
typedef float f32x2_t __attribute__((ext_vector_type(2)));
typedef __bf16 bf16x2_t __attribute__((ext_vector_type(2)));
__device__ __forceinline__ unsigned cvtpk(float lo, float hi) { f32x2_t v = {lo, hi}; bf16x2_t b = __builtin_convertvector(v, bf16x2_t); return __builtin_bit_cast(unsigned, b); }
__device__ __forceinline__ bf16x8 pack8(const f32x16& x, int s) {
    u32x4 p; p.x = cvtpk(x[8 * s], x[8 * s + 1]); p.y = cvtpk(x[8 * s + 2], x[8 * s + 3]); p.z = cvtpk(x[8 * s + 4], x[8 * s + 5]); p.w = cvtpk(x[8 * s + 6], x[8 * s + 7]);
    return __builtin_bit_cast(bf16x8, p);
}
__device__ __forceinline__ int scan_base(int s, int dir, int b) {
    if (s < 8) return MLAT + b * TC + 32 * (dir ? 7 - s : s);
    return b * T + 32 * (dir ? 63 - (s - 8) : s - 8);
}
__device__ __forceinline__ const bf16* fptr(const bf16* F, int col, size_t row) { return F + ((size_t)(col >> 7) * FMROWS + row) * 128 + (col & 127); }
template <int DK>
__device__ __forceinline__ void scan_item(const Args& a, LAS unsigned char* lds, const int b, const int head) {
    constexpr bool HGR = (DK == 128);
    constexpr int TPT = DK / 8, NG = 32 / TPT, QS = DK + 8, TS = 40;
    constexpr int VS = 136;
    constexpr int OFF_QD = 0, OFF_KI = OFF_QD + 32 * QS * 2, OFF_KT = OFF_KI + 32 * QS * 2, OFF_VT = OFF_KT + DK * TS * 2, OFF_DEC = OFF_VT + 128 * TS * 2,
                  OFF_CS = OFF_DEC + DK * 4, OFF_SSQ = OFF_CS + NG * DK * 4, OFF_RQ = OFF_SSQ + 512, OFF_RK = OFF_RQ + 32 * QS * 2, OFF_RV = OFF_RK + 32 * QS * 2,
                  OFF_RL = OFF_RV + 32 * VS * 2, OFF_ZL = OFF_RL + 32 * 16 * 2, DIRB = 68608;
    static_assert((HGR ? OFF_ZL : OFF_ZL + 32 * 64 * 4) <= DIRB - 512 && 2 * DIRB <= LDS_BYTES, "scan LDS map");
    const int tid = threadIdx.x, lane = tid & 63, wave = tid >> 6, dir = wave >> 2, dvq = wave & 3, gt = tid & 255;
    const int l31 = lane & 31, h = lane >> 5;
    LAS unsigned char* L = lds + dir * DIRB;
    LAS bf16* QD = (LAS bf16*)(L + OFF_QD); LAS bf16* KI = (LAS bf16*)(L + OFF_KI); LAS bf16* KT = (LAS bf16*)(L + OFF_KT); LAS bf16* VT = (LAS bf16*)(L + OFF_VT);
    LAS float* DEC = (LAS float*)(L + OFF_DEC); LAS float* CS = (LAS float*)(L + OFF_CS); LAS float* SSQ = (LAS float*)(L + OFF_SSQ);
    LAS bf16* RQ = (LAS bf16*)(L + OFF_RQ); LAS bf16* RK = (LAS bf16*)(L + OFF_RK); LAS bf16* RV = (LAS bf16*)(L + OFF_RV); LAS bf16* RL = (LAS bf16*)(L + OFF_RL); LAS float* ZL = (LAS float*)(L + OFF_ZL);
    const bf16* F = (const bf16*)(a.ws + WS_FEAT);
    bf16* OB = (bf16*)(a.ws + WS_OB); bf16* MG = (bf16*)(a.ws + WS_H);
    const int c = gt % DK, tg = gt / DK;
    const int vn = gt & 127, vth = gt >> 7;
    float abias = 0.f;
    const int lrw = dir ? 2 : 0;
    bf16x8 a2b[2];
#pragma unroll
    for (int j = 0; j < 2; ++j) a2b[j] = (bf16x8){0, 0, 0, 0, 0, 0, 0, 0};
    if (!HGR) { const float* a2 = dir ? a.a2_b : a.a2_f;
        if (dvq == lrw) {
#pragma unroll
            for (int j = 0; j < 2; ++j) { const float* ap = a2 + (8 * h) * 256 + head * 64 + 32 * j + l31; u32x4 w;
                w.x = cvtpk(ap[0], ap[256]); w.y = cvtpk(ap[512], ap[768]); w.z = cvtpk(ap[1024], ap[1280]); w.w = cvtpk(ap[1536], ap[1792]); a2b[j] = __builtin_bit_cast(bf16x8, w); } }
        abias = (dir ? a.abias_b : a.abias_f)[head * 64 + c]; }
    const int qcol0 = HGR ? HQ + head * 128 : GQ + head * 64;
    const int kcol0 = HGR ? (dir ? HFB : HFF) + head * 128 : GK + head * 64;
    const int vcol0 = (HGR ? HI : GV) + head * 128;
    const int lrcol = dir ? LRB : LRF;
    const int gcol = (HGR ? HG : GG) + head * 128;
    const int mcol = (HGR ? 512 : 0) + head * 128;
    const float* gain = HGR ? a.hgrn_gain : a.gla_gain;
    const float qscale = HGR ? 0.08838834764831845f : 0.125f;

    LAS float* GN = (LAS float*)(L + DIRB - 512);
    if (gt < 128) GN[gt] = gain[gt];
    f32x16 S[DK / 32];
#pragma unroll
    for (int t = 0; t < DK / 32; ++t)
#pragma unroll
        for (int r = 0; r < 16; ++r) S[t][r] = 0.f;

    constexpr int NVQ = DK / 64, VPR = DK / 8;
    u32x4 Rq[NVQ], Rk[NVQ], Rv[2], Rl = (u32x4){0u, 0u, 0u, 0u};
#define SCAN_LOAD(s_) do { const int base_ = scan_base((s_), dir, b) + ((s_) < 8 ? 1152 : b * 36); \
        _Pragma("unroll") for (int i = 0; i < NVQ; ++i) { const int vid = gt + 256 * i, ti = vid / VPR, cv = vid % VPR; const size_t row = (size_t)(base_ + (dir ? 31 - ti : ti)); \
            Rq[i] = *(const u32x4*)fptr(F, qcol0 + 8 * cv, row); Rk[i] = *(const u32x4*)fptr(F, kcol0 + 8 * cv, row); } \
        _Pragma("unroll") for (int i = 0; i < 2; ++i) { const int vid = gt + 256 * i, ti = vid >> 4, cv = vid & 15; const size_t row = (size_t)(base_ + (dir ? 31 - ti : ti)); \
            Rv[i] = *(const u32x4*)fptr(F, vcol0 + 8 * cv, row); } \
        if (!HGR && dvq == lrw) { const int ti = lane >> 1; const size_t row = (size_t)(base_ + (dir ? 31 - ti : ti)); Rl = *(const u32x4*)fptr(F, lrcol + 8 * (lane & 1), row); } } while (0)
#define SCAN_STORE_RAW() do { \
        _Pragma("unroll") for (int i = 0; i < NVQ; ++i) { const int vid = gt + 256 * i, ti = vid / VPR, cv = vid % VPR; *(LAS u32x4*)(RQ + ti * QS + 8 * cv) = Rq[i]; *(LAS u32x4*)(RK + ti * QS + 8 * cv) = Rk[i]; } \
        _Pragma("unroll") for (int i = 0; i < 2; ++i) { const int vid = gt + 256 * i, ti = vid >> 4, cv = vid & 15; *(LAS u32x4*)(RV + ti * VS + 8 * cv) = Rv[i]; } \
        if (!HGR && dvq == lrw) { *(LAS u32x4*)(RL + (lane >> 1) * 16 + 8 * (lane & 1)) = Rl; \
            asm volatile("s_waitcnt lgkmcnt(0)" ::: "memory"); \
            const bf16x8 la_ = *(const LAS bf16x8*)(RL + l31 * 16 + 8 * h); \
            _Pragma("unroll") for (int j = 0; j < 2; ++j) { f32x16 z_; _Pragma("unroll") for (int r = 0; r < 16; ++r) z_[r] = 0.f; \
                z_ = MFMA32(la_, a2b[j], z_); \
                _Pragma("unroll") for (int r = 0; r < 16; ++r) ZL[((r & 3) + 8 * (r >> 2) + 4 * h) * 64 + 32 * j + l31] = z_[r]; } } } while (0)
    SCAN_LOAD(0);
    SCAN_STORE_RAW();
    __syncthreads();
    for (int s = 0; s < 72; ++s) {
        const bool is_out = s >= 8, second = s >= 40;
        const int base = scan_base(s, dir, b);
        const size_t orow = (size_t)(base + (dir ? 31 - l31 : l31));
        u32x2 pob[4], pgt[4];
#pragma unroll
        for (int g4 = 0; g4 < 4; ++g4) { pob[g4] = (u32x2){0u, 0u}; pgt[g4] = (u32x2){0u, 0u}; }
        if (is_out && second) {
#pragma unroll
            for (int g4 = 0; g4 < 4; ++g4) { const int vc = 32 * dvq + 8 * g4 + 4 * h;
                pob[g4] = *(const u32x2*)(OB + ((size_t)(mcol >> 7) * MLAT + orow) * 128 + vc); pgt[g4] = *(const u32x2*)fptr(F, gcol + vc, orow + b * 36); }
        }
        if (s + 1 < 72) SCAN_LOAD(s + 1);
        float bl[TPT], qv[TPT], kv[TPT]; float run = HGR ? 1.f : 0.f;
#pragma unroll
        for (int i = 0; i < TPT; ++i) {
            const int ti = tg * TPT + i;
            const float q = bf2f(RQ[ti * QS + c]), k = bf2f(RK[ti * QS + c]);
            if (HGR) { run *= (1.0f - k); }
            else { const float z = abias + ZL[ti * 64 + c];
                run += (fminf(z, 0.f) * 1.44269504089f - __builtin_amdgcn_logf(1.0f + __builtin_amdgcn_exp2f(-1.44269504089f * fabsf(z)))) * 0.0625f; }
            bl[i] = run; qv[i] = q; kv[i] = k;
        }
        CS[tg * DK + c] = run;
        { u32x4 w0, w1; unsigned short rv[16];
#pragma unroll
          for (int i = 0; i < 16; ++i) rv[i] = RV[(16 * vth + i) * VS + vn];
          w0.x = rv[0] | ((unsigned)rv[1] << 16); w0.y = rv[2] | ((unsigned)rv[3] << 16); w0.z = rv[4] | ((unsigned)rv[5] << 16); w0.w = rv[6] | ((unsigned)rv[7] << 16);
          w1.x = rv[8] | ((unsigned)rv[9] << 16); w1.y = rv[10] | ((unsigned)rv[11] << 16); w1.z = rv[12] | ((unsigned)rv[13] << 16); w1.w = rv[14] | ((unsigned)rv[15] << 16);
          *(LAS u32x4*)(VT + vn * TS + 16 * vth) = w0; *(LAS u32x4*)(VT + vn * TS + 16 * vth + 8) = w1; }
        BAR_LDS();
        float prefix = HGR ? 1.f : 0.f, btot = HGR ? 1.f : 0.f;
#pragma unroll
        for (int t = 0; t < NG; ++t) { const float v = CS[t * DK + c]; if (HGR) { btot *= v; if (t < tg) prefix *= v; } else { btot += v; if (t < tg) prefix += v; } }
        const float dec = HGR ? btot : __builtin_amdgcn_exp2f(btot);
        unsigned ktp[TPT / 2], wqp[TPT / 2], wkp[TPT / 2];
#pragma unroll
        for (int i = 0; i < TPT; i += 2) {
            const float e0 = HGR ? prefix * bl[i] : __builtin_amdgcn_exp2f(prefix + bl[i]), e1 = HGR ? prefix * bl[i + 1] : __builtin_amdgcn_exp2f(prefix + bl[i + 1]);
            const float ki0 = kv[i] * __builtin_amdgcn_rcpf(e0), ki1 = kv[i + 1] * __builtin_amdgcn_rcpf(e1);
            wqp[i >> 1] = cvtpk(qv[i] * e0, qv[i + 1] * e1); wkp[i >> 1] = cvtpk(ki0, ki1);
            ktp[i >> 1] = cvtpk(ki0 * dec, ki1 * dec);
        }
        if (is_out) {
#pragma unroll
            for (int i = 0; i < TPT; i += 2) { const int ti = tg * TPT + i;
                QD[ti * QS + c] = (bf16)(wqp[i >> 1] & 0xffffu); QD[(ti + 1) * QS + c] = (bf16)(wqp[i >> 1] >> 16);
                KI[ti * QS + c] = (bf16)(wkp[i >> 1] & 0xffffu); KI[(ti + 1) * QS + c] = (bf16)(wkp[i >> 1] >> 16); }
        }
#pragma unroll
        for (int i = 0; i < TPT / 8; ++i) { u32x4 w; w.x = ktp[4 * i]; w.y = ktp[4 * i + 1]; w.z = ktp[4 * i + 2]; w.w = ktp[4 * i + 3]; *(LAS u32x4*)(KT + c * TS + tg * TPT + 8 * i) = w; }
        if (tg == 0) DEC[c] = dec;
        BAR_LDS();
#define SB() __builtin_amdgcn_sched_barrier(0)
        f32x16 OT;
#pragma unroll
        for (int r = 0; r < 16; ++r) OT[r] = 0.f;
        if (is_out) {
            f32x16 accT0;
#pragma unroll
            for (int r = 0; r < 16; ++r) accT0[r] = 0.f;
#pragma unroll
            for (int hb = 0; hb < DK / 64; ++hb) {
                bf16x8 kia[4], qdb[4];
#pragma unroll
                for (int s2 = 0; s2 < 4; ++s2) { kia[s2] = *(const LAS bf16x8*)(KI + l31 * QS + 64 * hb + 16 * s2 + 8 * h); qdb[s2] = *(const LAS bf16x8*)(QD + l31 * QS + 64 * hb + 16 * s2 + 8 * h); }
                SB();
#pragma unroll
                for (int s2 = 0; s2 < 4; ++s2) accT0 = MFMA32(kia[s2], qdb[s2], accT0);
            }
            s16x4 vlo[2], vhi[2];
#pragma unroll
            for (int u = 0; u < 2; ++u) { vlo[u] = *(const LAS s16x4*)(VT + (32 * dvq + l31) * TS + 16 * u + 4 * h); vhi[u] = *(const LAS s16x4*)(VT + (32 * dvq + l31) * TS + 16 * u + 8 + 4 * h); }
#pragma unroll
            for (int tb = 0; tb < DK / 64; ++tb) {
                s16x4 qlo[2][2], qhi[2][2];
#pragma unroll
                for (int t = 0; t < 2; ++t)
#pragma unroll
                    for (int u = 0; u < 2; ++u) { qlo[t][u] = *(const LAS s16x4*)(QD + l31 * QS + 64 * tb + 32 * t + 16 * u + 4 * h); qhi[t][u] = *(const LAS s16x4*)(QD + l31 * QS + 64 * tb + 32 * t + 16 * u + 8 + 4 * h); }
                SB();
#pragma unroll
                for (int t = 0; t < 2; ++t) {
                    const bf16x8 sa0 = pack8(S[2 * tb + t], 0), sa1 = pack8(S[2 * tb + t], 1);
                    OT = MFMA32(sa0, __builtin_shufflevector(qlo[t][0], qhi[t][0], 0, 1, 2, 3, 4, 5, 6, 7), OT);
                    OT = MFMA32(sa1, __builtin_shufflevector(qlo[t][1], qhi[t][1], 0, 1, 2, 3, 4, 5, 6, 7), OT);
                }
            }
#pragma unroll
            for (int r = 0; r < 16; ++r) { const int j = (r & 3) + 8 * (r >> 2) + 4 * h; if (j > l31) accT0[r] = 0.f; }
            OT = MFMA32(__builtin_shufflevector(vlo[0], vhi[0], 0, 1, 2, 3, 4, 5, 6, 7), pack8(accT0, 0), OT);
            OT = MFMA32(__builtin_shufflevector(vlo[1], vhi[1], 0, 1, 2, 3, 4, 5, 6, 7), pack8(accT0, 1), OT);
        }
        {
            bf16x8 vtb[2];
#pragma unroll
            for (int u = 0; u < 2; ++u) vtb[u] = *(const LAS bf16x8*)(VT + (32 * dvq + l31) * TS + 16 * u + 8 * h);
#pragma unroll
            for (int tb = 0; tb < DK / 64; ++tb) {
                bf16x8 kta[2][2];
#pragma unroll
                for (int t = 0; t < 2; ++t)
#pragma unroll
                    for (int u = 0; u < 2; ++u) kta[t][u] = *(const LAS bf16x8*)(KT + (64 * tb + 32 * t + l31) * TS + 16 * u + 8 * h);
#pragma unroll
                for (int t = 0; t < 2; ++t)
#pragma unroll
                    for (int g4 = 0; g4 < 4; ++g4) { const f32x4 d4 = *(const LAS f32x4*)(DEC + 64 * tb + 32 * t + 8 * g4 + 4 * h); const int tt = 2 * tb + t;
                        S[tt][4 * g4] *= d4.x; S[tt][4 * g4 + 1] *= d4.y; S[tt][4 * g4 + 2] *= d4.z; S[tt][4 * g4 + 3] *= d4.w; }
                SB();
#pragma unroll
                for (int u = 0; u < 2; ++u)
#pragma unroll
                    for (int t = 0; t < 2; ++t) S[2 * tb + t] = MFMA32(kta[t][u], vtb[u], S[2 * tb + t]);
            }
        }
#undef SB
        if (is_out) {
            const size_t row = orow;
            if (!second) {
#pragma unroll
                for (int g4 = 0; g4 < 4; ++g4) { u32x2 w; w.x = cvtpk(OT[4 * g4], OT[4 * g4 + 1]); w.y = cvtpk(OT[4 * g4 + 2], OT[4 * g4 + 3]);
                    *(u32x2*)(OB + ((size_t)(mcol >> 7) * MLAT + row) * 128 + 32 * dvq + 8 * g4 + 4 * h) = w; }
            } else {
                float ss = 0.f;
#pragma unroll
                for (int g4 = 0; g4 < 4; ++g4) { const u32x2 w = pob[g4];
                    OT[4 * g4] += __builtin_bit_cast(float, w.x << 16); OT[4 * g4 + 1] += __builtin_bit_cast(float, w.x & 0xffff0000u);
                    OT[4 * g4 + 2] += __builtin_bit_cast(float, w.y << 16); OT[4 * g4 + 3] += __builtin_bit_cast(float, w.y & 0xffff0000u); }
#pragma unroll
                for (int r = 0; r < 16; ++r) ss += OT[r] * OT[r];
                ss += __shfl_xor(ss, 32);
                if (h == 0) SSQ[dvq * 32 + l31] = ss;
                BAR_LDS();
                const float tot = (SSQ[l31] + SSQ[32 + l31]) + (SSQ[64 + l31] + SSQ[96 + l31]);
                const float rs = 1.0f / sqrtf(tot * (1.0f / 128.0f) + NORM_EPS);
#pragma unroll
                for (int g4 = 0; g4 < 4; ++g4) { const int vc = 32 * dvq + 8 * g4 + 4 * h;
                    const u32x2 gw = pgt[g4]; const f32x4 gn = *(const LAS f32x4*)(GN + vc);
                    const float y0 = OT[4 * g4] * rs * gn.x * __builtin_bit_cast(float, gw.x << 16), y1 = OT[4 * g4 + 1] * rs * gn.y * __builtin_bit_cast(float, gw.x & 0xffff0000u);
                    const float y2 = OT[4 * g4 + 2] * rs * gn.z * __builtin_bit_cast(float, gw.y << 16), y3 = OT[4 * g4 + 3] * rs * gn.w * __builtin_bit_cast(float, gw.y & 0xffff0000u);
                    u32x2 w; w.x = cvtpk(y0, y1); w.y = cvtpk(y2, y3);
                    *(u32x2*)(MG + row * D + mcol + vc) = w; }
            }
        }
        if (s + 1 < 72) SCAN_STORE_RAW();
        if (s == 39) __syncthreads(); else BAR_LDS();
    }
#undef SCAN_LOAD
#undef SCAN_STORE_RAW
}

__global__ void __launch_bounds__(512, 2) mega(Args a) {
    extern __shared__ __attribute__((aligned(16))) unsigned char lds_raw[];
    LAS unsigned char* lds = (LAS unsigned char*)lds_raw;
    cg::grid_group grid = cg::this_grid();
    unsigned char* ws = a.ws;
    const int lo = a.ph_lo, hi = a.ph_hi;
#define IN(k) (lo <= (k) && (k) < hi)
#define SEAM(k) do { if (IN(k) && IN((k) + 1)) { if ((k) == 0) grid.sync(); else xcd_barrier(bar); } } while (0)
    volatile LAS unsigned* MISC = (volatile LAS unsigned*)(lds + LDS_BYTES - 64);
    if (threadIdx.x < 16) MISC[threadIdx.x] = 0u;
    __syncthreads();
    XcdBarrier bar = xcd_barrier_post((unsigned*)(a.ws + WS_BAR), MISC);
    float* xc = (float*)(ws + WS_XC); const float* mt = (const float*)(ws + WS_M);
    pg8::bf16_t* H = (pg8::bf16_t*)(ws + WS_H); pg8::bf16_t* HID = (pg8::bf16_t*)(ws + WS_FEAT); pg8::bf16_t* FEAT = (pg8::bf16_t*)(ws + WS_FEAT);
    const int G = gridDim.x, cu = blockIdx.x;

    if (IN(0)) p0_prologue(a, lds);
    SEAM(0);
    if (IN(1)) ln_pass<0>(a, 0, 0, MALL);
    SEAM(1);
    if (IN(2)) { pg8::Gemm g{H, (const pg8::bf16_t*)(ws + WS_W1IN), MALL, 2 * DFF, D}; pg8::StaticOrder S; S.init(MALL, 2 * DFF, G, cu);
        pg8::EpiSwiGLU E{HID, DFF}; pg8::gemm_phase<pg8::EpiSwiGLU, pg8::StaticOrder, true, true>(lds, g, S, E); }
    SEAM(2);
    if (IN(3)) { pg8::Gemm g{HID, (const pg8::bf16_t*)(ws + WS_W1OUT), MALL, D, DFF}; pg8::StaticOrder S; S.init(MALL, D, G, cu);
        pg8::EpiResid E{a.out, xc, mt, 2, 0.5f, DN_ALPHA, a.x, a.ctx, (const float*)(ws + WS_TAB), nullptr, nullptr, nullptr}; pg8::gemm_phase<pg8::EpiResid, pg8::StaticOrder, true, true>(lds, g, S, E); }
    SEAM(3);
    if (IN(4)) ln_pass<1>(a, 1, 0, MALL);
    SEAM(4);
    if (IN(5)) { pg8::Gemm g{H, (const pg8::bf16_t*)(ws + WS_WMIX), MALL, FW, D}; pg8::MixOrder S; S.init(G, cu);
        pg8::EpiFeat E{FEAT, FMROWS, (const float*)(ws + WS_TAB + 256 * 1024)}; pg8::gemm_phase<pg8::EpiFeat, pg8::MixOrder, true, true>(lds, g, S, E); }
    SEAM(5);
    if (IN(6)) {
        if (cu < 256) { const int item = cu; const int b = item >> 3, grp = (item >> 2) & 1, head = item & 3;
            if (grp) scan_item<128>(a, lds, b, head); else scan_item<64>(a, lds, b, head); }
    }
    SEAM(6);
    if (IN(7)) { pg8::Gemm g{H, (const pg8::bf16_t*)(ws + WS_WMO), MLAT, D, D}; pg8::StaticOrder S; S.init(MLAT, D, G, cu);
        pg8::EpiResid E{a.out, xc, mt, 5, 1.0f, DN_ALPHA, nullptr, nullptr, nullptr, (const float*)(ws + WS_STATS), a.ln_gain, a.ln_bias}; pg8::gemm_phase<pg8::EpiResid, pg8::StaticOrder, true, true>(lds, g, S, E); }
    SEAM(7);
    if (IN(8)) ln_pass<1>(a, 2, 1, MLAT);
    SEAM(8);
    if (IN(9)) { pg8::Gemm g{H, (const pg8::bf16_t*)(ws + WS_W2IN), MLAT, 2 * DFF, D}; pg8::StaticOrder S; S.init(MLAT, 2 * DFF, G, cu);
        pg8::EpiSwiGLU E{HID, DFF}; pg8::gemm_phase<pg8::EpiSwiGLU, pg8::StaticOrder, true, true>(lds, g, S, E); }
    SEAM(9);
    if (IN(10)) { pg8::Gemm g{HID, (const pg8::bf16_t*)(ws + WS_W2OUT), MLAT, D, DFF}; pg8::StaticOrder S; S.init(MLAT, D, G, cu);
        pg8::EpiResid E{a.out, xc, mt, 8, 0.5f, DN_ALPHA, nullptr, nullptr, nullptr, (const float*)(ws + WS_STATS), a.ln_gain + D, a.ln_bias + D}; pg8::gemm_phase<pg8::EpiResid, pg8::StaticOrder, true, true>(lds, g, S, E); }
    SEAM(10);
    if (IN(11)) ln_pass<2>(a, 0, 2, MLAT);
#undef IN
#undef SEAM
}

extern "C" void kernel_launch(void* const* d_in, const int* in_sizes, int n_in, void* d_out, int out_size, void* d_ws, size_t ws_size, hipStream_t stream) {
    static int grid = 0;
    if (grid == 0) {
        if (n_in != 21 || out_size != MLAT * D || ws_size < WS_END) { fprintf(stderr, "kernel_launch: unexpected shapes: n_in %d out %d ws %zu (need %zu)\n", n_in, out_size, ws_size, (size_t)WS_END); grid = -1; return; }
        int dev = 0, cus = 0, per_cu = 0;
        (void)hipGetDevice(&dev); (void)hipDeviceGetAttribute(&cus, hipDeviceAttributeMultiprocessorCount, dev);
        (void)hipFuncSetAttribute((const void*)mega, hipFuncAttributeMaxDynamicSharedMemorySize, LDS_BYTES);
        (void)hipOccupancyMaxActiveBlocksPerMultiprocessor(&per_cu, (const void*)mega, 512, LDS_BYTES);
        (void)hipGetLastError();
        grid = cus > 0 ? cus : 256; if (grid < 256) fprintf(stderr, "kernel_launch: this kernel needs >= 256 CUs (scan phase: one item per workgroup)\n");
        if (per_cu < 1) fprintf(stderr, "kernel_launch: occupancy query reports %d blocks per CU\n", per_cu);
    }
    if (grid < 0) return;
    if (hipMemsetAsync((char*)d_ws + WS_BAR, 0, 16384, stream) != hipSuccess) { fprintf(stderr, "kernel_launch: hipMemsetAsync of the barrier words failed\n"); return; }
    Args a{};
    const float** p = (const float**)&a;
    for (int i = 0; i < 21; ++i) p[i] = (const float*)d_in[i];
    a.out = (float*)d_out; a.ws = (unsigned char*)d_ws; a.ph_lo = 0; a.ph_hi = 12;
    void* args[] = {&a};
    hipError_t e = hipLaunchCooperativeKernel((void*)mega, dim3(grid), dim3(512), args, LDS_BYTES, stream);
    if (e != hipSuccess) fprintf(stderr, "cooperative launch failed: %s (grid %d)\n", hipGetErrorString(e), grid);
}
```
